# Optimizing an MI355X kernel written in HIP

```python
import math
import jax, jax.numpy as jnp
from jax import lax
import numpy as np

D_MODEL = 1024
BATCH = 16
SEQ = 2048
DEPTH = 1

N_HEADS = 8
HEAD_DIM = 64
QK_WIDTH = N_HEADS * 2 * HEAD_DIM
V_HEAD_DIM = 2 * HEAD_DIM
V_WIDTH = N_HEADS * V_HEAD_DIM
ROT_DIM = HEAD_DIM // 4
ROPE_THETA = 500000.0
Q_BLOCK = 128

CONV_C = D_MODEL
CONV_W = 31

N_BRANCH = 2
D_FF = int(math.ceil(8 * D_MODEL / 3 / 256) * 256)

IN_COLS = 2 * CONV_C + 2 * QK_WIDTH + V_WIDTH + N_BRANCH * D_MODEL

kernel_name = "hybrid_conformer_diffattn_gated_block"


def rmsnorm(x, g, eps=1e-6):
    xf = x.astype(jnp.float32)
    y = xf * lax.rsqrt(jnp.mean(xf * xf, axis=-1, keepdims=True) + eps)
    return (y * g.astype(jnp.float32)).astype(x.dtype)


def layernorm(x, g, b, eps=1e-5):
    xf = x.astype(jnp.float32)
    mu = jnp.mean(xf, axis=-1, keepdims=True)
    xc = xf - mu
    var = jnp.mean(xc * xc, axis=-1, keepdims=True)
    y = xc * lax.rsqrt(var + eps) * g.astype(jnp.float32) + b.astype(jnp.float32)
    return y.astype(x.dtype)


def rope_tables(seq_len):
    inv_freq = ROPE_THETA ** (-jnp.arange(0, ROT_DIM, 2, dtype=jnp.float32) / ROT_DIM)
    pos = jnp.arange(seq_len, dtype=jnp.float32)
    ang = pos[:, None] * inv_freq[None, :]
    return jnp.cos(ang)[:, None, None, :], jnp.sin(ang)[:, None, None, :]


def apply_partial_rope(t, cos, sin):
    cos = cos.astype(t.dtype)
    sin = sin.astype(t.dtype)
    tr, tp = t[..., :ROT_DIM], t[..., ROT_DIM:]
    t1, t2 = tr[..., : ROT_DIM // 2], tr[..., ROT_DIM // 2:]
    rot = jnp.concatenate([t1 * cos - t2 * sin, t2 * cos + t1 * sin], axis=-1)
    return jnp.concatenate([rot, tp], axis=-1)


def conformer_conv_branch(u_glu, w_dw, b_dw, g_ln, b_ln, w_pw):
    a, gate = jnp.split(u_glu, 2, axis=-1)
    u = a * jax.nn.sigmoid(gate)
    u = lax.conv_general_dilated(
        u, w_dw[:, None, :].astype(u.dtype), window_strides=(1,),
        padding=[(CONV_W - 1, 0)],
        dimension_numbers=("NWC", "WIO", "NWC"),
        feature_group_count=CONV_C) + b_dw
    u = layernorm(u, g_ln, b_ln)
    u = jax.nn.silu(u)
    return u @ w_pw


def diff_attention(q, k, v, lam):
    seq_len = q.shape[1]
    scale = HEAD_DIM ** -0.5
    neg = jnp.finfo(jnp.float32).min
    outs = []
    for i in range(seq_len // Q_BLOCK):
        kv_len = (i + 1) * Q_BLOCK
        qs = q[:, i * Q_BLOCK:(i + 1) * Q_BLOCK]
        ks = k[:, :kv_len]
        vs = v[:, :kv_len]
        s = jnp.einsum("bqhcd,bkhcd->bhcqk", qs, ks).astype(jnp.float32) * scale
        qpos = i * Q_BLOCK + jnp.arange(Q_BLOCK)
        kpos = jnp.arange(kv_len)
        mask = kpos[None, :] <= qpos[:, None]
        s = jnp.where(mask, s, neg)
        p = jax.nn.softmax(s, axis=-1)
        a = p[:, :, 0] - lam * p[:, :, 1]
        outs.append(jnp.einsum("bhqk,bkhe->bqhe", a.astype(v.dtype), vs))
    return jnp.concatenate(outs, axis=1)


def setup_inputs(seed: int = 0) -> dict:
    key = jax.random.key(seed)
    ks = jax.random.split(key, 24)
    f32 = jnp.float32
    D, L = D_MODEL, DEPTH

    def nrm(k, shape, scale):
        return jax.random.normal(k, shape, f32) * scale

    def gain(k, shape):
        return 1.0 + 0.02 * jax.random.normal(k, shape, f32)

    return {
        "x": jax.random.normal(ks[0], (BATCH, SEQ, D), f32),
        "g_mix": gain(ks[1], (L, D)),
        "w_in": nrm(ks[2], (L, D, IN_COLS), D ** -0.5),
        "b_gate": nrm(ks[3], (L, N_BRANCH * D), 0.02),
        "w_dw": nrm(ks[4], (L, CONV_W, CONV_C), CONV_W ** -0.5),
        "b_dw": nrm(ks[5], (L, CONV_C), 0.02),
        "g_conv_ln": gain(ks[6], (L, CONV_C)),
        "b_conv_ln": nrm(ks[7], (L, CONV_C), 0.02),
        "w_conv_pw": nrm(ks[8], (L, CONV_C, D), CONV_C ** -0.5),
        "lambda_q1": nrm(ks[9], (L, HEAD_DIM), 0.1),
        "lambda_k1": nrm(ks[10], (L, HEAD_DIM), 0.1),
        "lambda_q2": nrm(ks[11], (L, HEAD_DIM), 0.1),
        "lambda_k2": nrm(ks[12], (L, HEAD_DIM), 0.1),
        "g_subln": gain(ks[13], (L, V_HEAD_DIM)),
        "w_attn_pw": nrm(ks[14], (L, V_WIDTH, D), V_WIDTH ** -0.5),
        "w_out": nrm(ks[15], (L, D, D), D ** -0.5),
        "g_ffn": gain(ks[16], (L, D)),
        "w_ffn_gate": nrm(ks[17], (L, D, D_FF), D ** -0.5),
        "w_ffn_up": nrm(ks[18], (L, D, D_FF), D ** -0.5),
        "w_ffn_down": nrm(ks[19], (L, D_FF, D), D_FF ** -0.5),
        "g_final": gain(ks[20], (D,)),
    }


def reference(x, g_mix, w_in, b_gate, w_dw, b_dw, g_conv_ln, b_conv_ln, w_conv_pw,
              lambda_q1, lambda_k1, lambda_q2, lambda_k2, g_subln, w_attn_pw, w_out,
              g_ffn, w_ffn_gate, w_ffn_up, w_ffn_down, g_final):
    bsz, seq_len, _ = x.shape
    cos, sin = rope_tables(seq_len)
    c0 = 2 * CONV_C
    c1 = c0 + QK_WIDTH
    c2 = c1 + QK_WIDTH
    c3 = c2 + V_WIDTH
    for l in range(DEPTH):
        lambda_init = 0.8 - 0.6 * math.exp(-0.3 * l)
        h = rmsnorm(x, g_mix[l])
        z = h @ w_in[l]
        z_conv = z[..., :c0]
        q = z[..., c0:c1].reshape(bsz, seq_len, N_HEADS, 2, HEAD_DIM)
        k = z[..., c1:c2].reshape(bsz, seq_len, N_HEADS, 2, HEAD_DIM)
        v = z[..., c2:c3].reshape(bsz, seq_len, N_HEADS, V_HEAD_DIM)
        gates = jax.nn.sigmoid(z[..., c3:] + b_gate[l])
        gate_conv, gate_attn = jnp.split(gates, N_BRANCH, axis=-1)

        y_conv = conformer_conv_branch(z_conv, w_dw[l], b_dw[l], g_conv_ln[l],
                                       b_conv_ln[l], w_conv_pw[l])

        q = apply_partial_rope(q, cos, sin)
        k = apply_partial_rope(k, cos, sin)
        lam = (jnp.exp(jnp.sum(lambda_q1[l].astype(jnp.float32) * lambda_k1[l].astype(jnp.float32)))
               - jnp.exp(jnp.sum(lambda_q2[l].astype(jnp.float32) * lambda_k2[l].astype(jnp.float32)))
               + lambda_init)
        o = diff_attention(q, k, v, lam)
        o = rmsnorm(o, g_subln[l]) * (1.0 - lambda_init)
        y_attn = o.reshape(bsz, seq_len, V_WIDTH) @ w_attn_pw[l]

        merged = gate_conv * y_conv + gate_attn * y_attn
        x = x + merged @ w_out[l]

        h2 = rmsnorm(x, g_ffn[l])
        ff = jax.nn.silu(h2 @ w_ffn_gate[l]) * (h2 @ w_ffn_up[l])
        x = x + ff @ w_ffn_down[l]
    return rmsnorm(x, g_final)
```

```cpp
#include <hip/hip_runtime.h>
#include <cstdio>
#include <cstdint>
namespace pg8 {
#define PG8_LAS __attribute__((address_space(3)))
typedef unsigned short bf16_t;
typedef short bf16x8 __attribute__((ext_vector_type(8)));
typedef float f32x4 __attribute__((ext_vector_type(4)));
typedef unsigned u32x4 __attribute__((ext_vector_type(4)));
constexpr int BM = 256, BK = 64, HALF = 128, HTB = HALF * BK * 2  , STAGE_BYTES = 8 * HTB, NXCD = 8, WGM = 8;

__host__ __device__ __forceinline__ int lds_byte(int r, int c) { const int st = (r >> 4) * 2 + (c >> 5), rr = r & 15, cc = c & 31, ob = rr * 64 + cc * 2; return st * 1024 + (ob ^ (((ob >> 9) & 1) << 5)); }
__host__ __device__ __forceinline__ void stage_rc(int b, int& R, int& C) { const int st = b / 1024, sb = b % 1024, swz = sb ^ (((sb >> 9) & 1) << 5); R = (st >> 1) * 16 + swz / 64; C = (st & 1) * 32 + (swz % 64) / 2; }
__host__ __device__ __forceinline__ int perm32(int rho) { const int n = rho >> 4, i = rho & 15; return 8 * (i >> 2) + 4 * n + (i & 3); }

struct Unit { int pm, pn; };
struct Gemm { const bf16_t* A; const bf16_t* Bt; int M, N, K; };

struct StaticOrder {
    int nM, nN, nwg, G, c;
    __host__ __device__ void init(int M, int N, int G_, int c_) { nM = M / BM; nN = N / BM; nwg = nM * nN; G = G_; c = c_; }
    __host__ __device__ bool next(int i, Unit& u) const {
        const long L = (long)i * G + c; if (L >= nwg) return false;
        int wgid = (int)L; { const int q = nwg / NXCD, r = nwg % NXCD, xcd = wgid % NXCD, off = wgid / NXCD; wgid = (xcd < r ? xcd * (q + 1) : r * (q + 1) + (xcd - r) * q) + off; }
        const int nig = WGM * nN, gid = wgid / nig, fm = gid * WGM, gsz = (nM - fm) < WGM ? (nM - fm) : WGM;
        u.pm = fm + ((wgid % nig) % gsz); u.pn = (wgid % nig) / gsz; return true;
    }
    __device__ __forceinline__ void a_ready(const Unit&) const {}
    __device__ __forceinline__ void done(const Unit&) const {}
};

__device__ __forceinline__ unsigned cvt_pk_bf16(float lo, float hi) { unsigned r; asm volatile("v_cvt_pk_bf16_f32 %0, %1, %2" : "=v"(r) : "v"(lo), "v"(hi)); return r; }
__device__ __forceinline__ float bf_lo(unsigned w) { return __uint_as_float(w << 16); }
__device__ __forceinline__ float bf_hi(unsigned w) { return __uint_as_float(w & 0xffff0000u); }
constexpr float LOG2E = 1.4426950408889634f;
__device__ __forceinline__ float ex2(float x) { return __builtin_amdgcn_exp2f(x); }
__device__ __forceinline__ float rcpf_(float x) { return __builtin_amdgcn_rcpf(x); }
__device__ __forceinline__ float sigm(float x) { return rcpf_(1.f + ex2(-x * LOG2E)); }
__device__ __forceinline__ u32x4 pack8(const f32x4 a, const f32x4 b) { u32x4 w; w.x = cvt_pk_bf16(a[0], a[1]); w.y = cvt_pk_bf16(a[2], a[3]); w.z = cvt_pk_bf16(b[0], b[1]); w.w = cvt_pk_bf16(b[2], b[3]); return w; }

constexpr int SEQ_ = 2048;
constexpr float QSCALE = 0.125f * 1.4426950408889634f;

struct EpiIn {
    static constexpr bool PERM = true, AFTER_DRAIN = false, MID = false;
    bf16_t* U; bf16_t* CA; bf16_t* Kp; bf16_t* Vp; bf16_t* G; const float* rs1; const float* bgate; const float* rope;
    __device__ __forceinline__ void operator()(const f32x4 (&acc)[2][2][4][2], const Unit& u, int wr, int wc, int fr, int fq) const {
        const int pn = u.pn, rowb = u.pm * BM + wr * 64 + fr;
        if (pn < 8) {
            bf16_t* base = U + pn * 128 + wc * 32 + fq * 8;
#pragma unroll
            for (int ai = 0; ai < 2; ++ai)
#pragma unroll
                for (int m = 0; m < 4; ++m) { const int r = rowb + ai * HALF + m * 16; const float rs = rs1[r]; f32x4 o[2];
#pragma unroll
                    for (int n = 0; n < 2; ++n) { const f32x4 a = acc[ai][0][m][n] * rs, g = acc[ai][1][m][n] * rs;
#pragma unroll
                        for (int e = 0; e < 4; ++e) o[n][e] = a[e] * sigm(g[e]); }
                    *(u32x4*)(base + (size_t)r * 1024) = pack8(o[0], o[1]); }
        } else if (pn < 16) {
            const bool isq = pn < 12; const bool dorope = ((wc & 1) == 0) && (fq < 2);
#pragma unroll
            for (int ai = 0; ai < 2; ++ai)
#pragma unroll
                for (int m = 0; m < 4; ++m) { const int r = rowb + ai * HALF + m * 16; const float rs = rs1[r]; const int pos = r & (SEQ_ - 1);
                    f32x4 cs0 = {1.f, 0.f, 1.f, 0.f}, cs1 = {1.f, 0.f, 1.f, 0.f};
                    if (dorope) { const float* rp = rope + ((size_t)pos * 8 + 4 * fq) * 2; cs0 = *(const f32x4*)rp; cs1 = *(const f32x4*)(rp + 4); }
#pragma unroll
                    for (int bj = 0; bj < 2; ++bj) { f32x4 v0 = acc[ai][bj][m][0] * rs, v1 = acc[ai][bj][m][1] * rs;
                        { const float a = v0[0], b = v0[1], c = v0[2], d = v0[3];
                          v0[0] = a * cs0[0] - b * cs0[1]; v0[1] = b * cs0[0] + a * cs0[1]; v0[2] = c * cs0[2] - d * cs0[3]; v0[3] = d * cs0[2] + c * cs0[3]; }
                        { const float a = v1[0], b = v1[1], c = v1[2], d = v1[3];
                          v1[0] = a * cs1[0] - b * cs1[1]; v1[1] = b * cs1[0] + a * cs1[1]; v1[2] = c * cs1[2] - d * cs1[3]; v1[3] = d * cs1[2] + c * cs1[3]; }
                        if (isq) { v0 = v0 * QSCALE; v1 = v1 * QSCALE;
                            *(u32x4*)(CA + (size_t)r * 2048 + 1024 + (pn - 8) * 256 + bj * HALF + wc * 32 + fq * 8) = pack8(v0, v1);
                        } else { const int b_ = r >> 11, tile = pos >> 6, row = pos & 63, h = 2 * (pn - 12) + bj, comp = wc >> 1, chunk = 4 * (wc & 1) + fq;
                            *(u32x4*)(Kp + ((size_t)((((b_ * 8 + h) * 32 + tile) * 2 + comp) * 8 + chunk) * 64 + row) * 8) = pack8(v0, v1); } } }
        } else if (pn < 20) {
#pragma unroll
            for (int ai = 0; ai < 2; ++ai)
#pragma unroll
                for (int m = 0; m < 4; ++m) { const int r = rowb + ai * HALF + m * 16; const float rs = rs1[r]; const int pos = r & (SEQ_ - 1), b_ = r >> 11, tile = pos >> 6, ks = (pos & 63) >> 4, r16 = pos & 15;
#pragma unroll
                    for (int bj = 0; bj < 2; ++bj) { const int h = 2 * (pn - 16) + bj; const f32x4 v0 = acc[ai][bj][m][0] * rs, v1 = acc[ai][bj][m][1] * rs;
                        *(u32x4*)(Vp + ((size_t)(((b_ * 8 + h) * 32 + tile) * 16 + wc * 4 + ks) * 16 + r16) * 32 + fq * 8) = pack8(v0, v1); } }
        } else {
            const int ch = (pn - 20) * 128 + wc * 32 + fq * 8;
            const f32x4 bc0 = *(const f32x4*)(bgate + ch), bc1 = *(const f32x4*)(bgate + ch + 4), ba0 = *(const f32x4*)(bgate + 1024 + ch), ba1 = *(const f32x4*)(bgate + 1024 + ch + 4);
#pragma unroll
            for (int ai = 0; ai < 2; ++ai)
#pragma unroll
                for (int m = 0; m < 4; ++m) { const int r = rowb + ai * HALF + m * 16; const float rs = rs1[r]; f32x4 rt[2], ga[2];
#pragma unroll
                    for (int n = 0; n < 2; ++n) { const f32x4 xc = acc[ai][0][m][n] * rs + (n ? bc1 : bc0), xa = acc[ai][1][m][n] * rs + (n ? ba1 : ba0);
#pragma unroll
                        for (int e = 0; e < 4; ++e) { const float ea = ex2(fminf(-xa[e] * LOG2E, 80.f)), ec = ex2(-xc[e] * LOG2E); ga[n][e] = rcpf_(1.f + ea); rt[n][e] = (1.f + ea) * rcpf_(1.f + ec); } }
                    *(u32x4*)(G + (size_t)r * 2048 + ch) = pack8(rt[0], rt[1]);
                    *(u32x4*)(G + (size_t)r * 2048 + 1024 + ch) = pack8(ga[0], ga[1]); }
        }
    }
};

struct EpiMerge {
    static constexpr bool PERM = true, AFTER_DRAIN = false, MID = true;
    const bf16_t* G; bf16_t* O;
    __device__ __forceinline__ void mid(f32x4 (&acc)[2][2][4][2], const Unit& u, int wr, int wc, int fr, int fq) const {
        asm volatile("" : "+v"(fr), "+v"(fq));
        const int rowb = u.pm * BM + wr * 64 + fr, col = u.pn * BM + wc * 32 + fq * 8;
#pragma unroll
        for (int ai = 0; ai < 2; ++ai)
#pragma unroll
            for (int m = 0; m < 4; ++m) { const bf16_t* gp = G + (size_t)(rowb + ai * HALF + m * 16) * 2048 + col;
#pragma unroll
                for (int bj = 0; bj < 2; ++bj) { const u32x4 w = *(const u32x4*)(gp + bj * HALF);
                    acc[ai][bj][m][0] *= (f32x4){bf_lo(w.x), bf_hi(w.x), bf_lo(w.y), bf_hi(w.y)}; acc[ai][bj][m][1] *= (f32x4){bf_lo(w.z), bf_hi(w.z), bf_lo(w.w), bf_hi(w.w)}; }
                if (m & 1) asm volatile("" ::: "memory"); }
    }
    __device__ __forceinline__ void operator()(const f32x4 (&acc)[2][2][4][2], const Unit& u, int wr, int wc, int fr, int fq) const {
        const int rowb = u.pm * BM + wr * 64 + fr, col = u.pn * BM + wc * 32 + fq * 8;
#pragma unroll
        for (int ai = 0; ai < 2; ++ai)
#pragma unroll
            for (int m = 0; m < 4; ++m) { const int r = rowb + ai * HALF + m * 16; const bf16_t* gp = G + (size_t)r * 2048 + 1024 + col;
#pragma unroll
                for (int bj = 0; bj < 2; ++bj) { const u32x4 w = *(const u32x4*)(gp + bj * HALF);
                    const f32x4 v0 = acc[ai][bj][m][0] * (f32x4){bf_lo(w.x), bf_hi(w.x), bf_lo(w.y), bf_hi(w.y)}, v1 = acc[ai][bj][m][1] * (f32x4){bf_lo(w.z), bf_hi(w.z), bf_lo(w.w), bf_hi(w.w)};
                    *(u32x4*)(O + (size_t)r * 1024 + col + bj * HALF) = pack8(v0, v1); } }
    }
};

struct EpiResid {
    static constexpr bool PERM = false, AFTER_DRAIN = false, MID = false;
    const float* base; float* out; bf16_t* ob; float* part;
    __device__ __forceinline__ void operator()(const f32x4 (&acc)[2][2][4][2], const Unit& u, int wr, int wc, int fr, int fq) const {
        const int rowb = u.pm * BM + wr * 64 + fr, col0 = u.pn * BM + wc * 32 + 4 * fq;
#pragma unroll
        for (int ai = 0; ai < 2; ++ai)
#pragma unroll
            for (int m = 0; m < 4; ++m) { const int r = rowb + ai * HALF + m * 16; const size_t off = (size_t)r * 1024 + col0; float ss = 0.f;
#pragma unroll
                for (int bj = 0; bj < 2; ++bj)
#pragma unroll
                    for (int n = 0; n < 2; ++n) { const size_t o2 = off + bj * HALF + n * 16; const f32x4 v = *(const f32x4*)(base + o2) + acc[ai][bj][m][n];
                        *(f32x4*)(out + o2) = v; ss += (v[0] * v[0] + v[1] * v[1]) + (v[2] * v[2] + v[3] * v[3]);
                        if (ob) { typedef unsigned u32x2v __attribute__((ext_vector_type(2))); u32x2v w; w.x = cvt_pk_bf16(v[0], v[1]); w.y = cvt_pk_bf16(v[2], v[3]); *(u32x2v*)(ob + o2) = w; } }
                ss += __shfl_xor(ss, 16); ss += __shfl_xor(ss, 32);
                if (fq == 0) part[(size_t)r * 16 + u.pn * 4 + wc] = ss; }
    }
};

struct EpiUp {
    static constexpr bool PERM = true, AFTER_DRAIN = false, MID = false;
    const float* part; bf16_t* FF; int ldf;
    __device__ __forceinline__ void operator()(const f32x4 (&acc)[2][2][4][2], const Unit& u, int wr, int wc, int fr, int fq) const {
        const int rowb = u.pm * BM + wr * 64 + fr; bf16_t* base = FF + u.pn * 128 + wc * 32 + fq * 8;
#pragma unroll
        for (int ai = 0; ai < 2; ++ai)
#pragma unroll
            for (int m = 0; m < 4; ++m) { const int r = rowb + ai * HALF + m * 16; const f32x4 pv = *(const f32x4*)(part + (size_t)r * 16 + 4 * fq);
                float s = (pv[0] + pv[1]) + (pv[2] + pv[3]); s += __shfl_xor(s, 16); s += __shfl_xor(s, 32);
                const float rs = 1.0f / sqrtf(s * (1.0f / 1024.0f) + 1e-6f); f32x4 o[2];
#pragma unroll
                for (int n = 0; n < 2; ++n) { const f32x4 g = acc[ai][0][m][n] * rs, up = acc[ai][1][m][n] * rs;
#pragma unroll
                    for (int e = 0; e < 4; ++e) o[n][e] = g[e] * sigm(g[e]) * up[e]; }
                *(u32x4*)(base + (size_t)r * ldf) = pack8(o[0], o[1]); }
    }
};

template <class Epi, class Sched, bool ALIGN_EPI = false, bool SP2 = false>
__device__ __forceinline__ void gemm_phase(PG8_LAS unsigned char* lds, const Gemm g, const Sched& S, const Epi& E) {
    const int tid = threadIdx.x, wid = __builtin_amdgcn_readfirstlane(tid >> 6), lane = tid & 63, wr = wid >> 2, wc = wid & 3, fr = lane & 15, fq = lane >> 4;
    const int K = g.K, nt = K / BK;
    unsigned voffA[2], voffB[2];
#pragma unroll
    for (int i = 0; i < 2; ++i) { int R, C; stage_rc(tid * 16 + i * 8192, R, C); const int Rb = Epi::PERM ? ((R & ~31) + perm32(R & 31)) : R;
        voffA[i] = (unsigned)(R * K + C) * 2u; voffB[i] = (unsigned)(Rb * K + C) * 2u; }
    const size_t kstep = (size_t)(BK * 2);
    const size_t hstep = (size_t)HALF * K * 2;
    const size_t tstep = 2 * hstep;
    const unsigned ldsw = (unsigned)wid * 1024u;
    const int aoff = lds_byte(wr * 64 + fr, fq * 8), boff = lds_byte(wc * 32 + fr, fq * 8);
#define PG8_SA(b, h) (((b) * 2 + (h)) * HTB)
#define PG8_SB(b, h) ((4 + (b) * 2 + (h)) * HTB)
#define PG8_STAGE(bufoff, gbase, voff) do { _Pragma("unroll") for (int _i = 0; _i < 2; ++_i) \
        __builtin_amdgcn_global_load_lds((const unsigned*)((const char*)(gbase) + (voff)[_i]), (PG8_LAS unsigned*)(lds + (bufoff) + ldsw + _i * 8192), 16, 0, 0); } while (0)
#define PG8_LDA(dst, b, h) do { _Pragma("unroll") for (int m = 0; m < 4; ++m) _Pragma("unroll") for (int k = 0; k < 2; ++k) dst[m][k] = *(const PG8_LAS bf16x8*)(lds + PG8_SA(b, h) + aoff + m * 2048 + k * 1024); } while (0)
#define PG8_LDB(dst, b, h) do { _Pragma("unroll") for (int n = 0; n < 2; ++n) _Pragma("unroll") for (int k = 0; k < 2; ++k) dst[n][k] = *(const PG8_LAS bf16x8*)(lds + PG8_SB(b, h) + boff + n * 2048 + k * 1024); } while (0)
#define PG8_MMA(ai, bj, At, Bt) do { __builtin_amdgcn_s_setprio(1); _Pragma("unroll") for (int m = 0; m < 4; ++m) _Pragma("unroll") for (int n = 0; n < 2; ++n) _Pragma("unroll") for (int k = 0; k < 2; ++k) \
        acc[ai][bj][m][n] = __builtin_amdgcn_mfma_f32_16x16x32_bf16(Bt[n][k], At[m][k], acc[ai][bj][m][n], 0, 0, 0); __builtin_amdgcn_s_setprio(0); } while (0)
#define PG8_WAIT_V(n) asm volatile("s_waitcnt vmcnt(" #n ")" ::: "memory")
#define PG8_WAIT_L(n) asm volatile("s_waitcnt lgkmcnt(" #n ")" ::: "memory")
#define PG8_BAR __builtin_amdgcn_s_barrier()
#define PG8_SCHED __builtin_amdgcn_sched_barrier(0)
    Unit cur, nxt; int ui = 0;
    if (!S.next(0, cur)) return;
    f32x4 acc[2][2][4][2];
#pragma unroll
    for (int a = 0; a < 2; ++a)
#pragma unroll
        for (int b = 0; b < 2; ++b)
#pragma unroll
            for (int m = 0; m < 4; ++m)
#pragma unroll
                for (int n = 0; n < 2; ++n) acc[a][b][m][n] = (f32x4){0.f, 0.f, 0.f, 0.f};
    bf16x8 At[4][2], B0[2][2], B1[2][2];
    const char* cA = (const char*)g.A + (size_t)cur.pm * tstep; const char* cB = (const char*)g.Bt + (size_t)cur.pn * tstep;
    S.a_ready(cur);
    if constexpr (SP2) {
        PG8_STAGE(PG8_SB(0, 0), cB, voffB); PG8_STAGE(PG8_SB(0, 1), cB + hstep, voffB); PG8_STAGE(PG8_SA(0, 0), cA, voffA); PG8_STAGE(PG8_SA(0, 1), cA + hstep, voffA);
        if (wr == 1) PG8_BAR;
        PG8_WAIT_V(2); PG8_BAR;
        PG8_STAGE(PG8_SB(1, 0), cB + kstep, voffB); PG8_STAGE(PG8_SA(1, 0), cA + kstep, voffA); PG8_STAGE(PG8_SB(1, 1), cB + hstep + kstep, voffB);
        PG8_WAIT_V(6); PG8_BAR;
    } else {
        PG8_STAGE(PG8_SB(0, 0), cB, voffB); PG8_STAGE(PG8_SA(0, 0), cA, voffA); PG8_STAGE(PG8_SB(0, 1), cB + hstep, voffB); PG8_STAGE(PG8_SA(0, 1), cA + hstep, voffA);
        if (wr == 1) PG8_BAR;
        PG8_WAIT_V(4); PG8_BAR;
        PG8_STAGE(PG8_SB(1, 0), cB + kstep, voffB); PG8_STAGE(PG8_SA(1, 0), cA + kstep, voffA); PG8_STAGE(PG8_SB(1, 1), cB + hstep + kstep, voffB);
        PG8_WAIT_V(6); PG8_BAR;
    }
    for (;;) {
        const bool has_next = S.next(ui + 1, nxt);
        const char* nA = has_next ? (const char*)g.A + (size_t)nxt.pm * tstep : cA; const char* nB = has_next ? (const char*)g.Bt + (size_t)nxt.pn * tstep : cB;
        for (int t = 0; t < nt; t += 2) {
            if constexpr (Epi::MID) { if (t == (nt >> 1)) E.mid(acc, cur, wr, wc, fr, fq); }
            const bool last = (t == nt - 2);
            const char* a1 = cA + (size_t)(t + 1) * kstep;
            const char* a2 = last ? nA : cA + (size_t)(t + 2) * kstep; const char* b2 = last ? nB : cB + (size_t)(t + 2) * kstep;
            const char* a3 = a2 + kstep; const char* b3 = b2 + kstep;
            if (last && has_next) S.a_ready(nxt);
            if constexpr (SP2) {
            PG8_LDB(B0, 0, 0); PG8_LDB(B1, 0, 1); PG8_SCHED; PG8_LDA(At, 0, 0); PG8_STAGE(PG8_SA(1, 1), a1 + hstep, voffA);
            PG8_WAIT_V(8); PG8_WAIT_L(0); PG8_BAR; PG8_MMA(0, 0, At, B0); PG8_MMA(0, 1, At, B1); PG8_BAR; PG8_SCHED;
            PG8_LDA(At, 0, 1); PG8_STAGE(PG8_SB(0, 0), b2, voffB); PG8_STAGE(PG8_SB(0, 1), b2 + hstep, voffB); PG8_STAGE(PG8_SA(0, 0), a2, voffA);
            PG8_WAIT_V(8); PG8_WAIT_L(0); PG8_BAR; PG8_MMA(1, 0, At, B0); PG8_MMA(1, 1, At, B1); PG8_BAR; PG8_SCHED;
            PG8_LDB(B0, 1, 0); PG8_LDB(B1, 1, 1); PG8_SCHED; PG8_LDA(At, 1, 0); PG8_STAGE(PG8_SA(0, 1), a2 + hstep, voffA);
            PG8_WAIT_V(8); PG8_WAIT_L(0); PG8_BAR; PG8_MMA(0, 0, At, B0); PG8_MMA(0, 1, At, B1); PG8_BAR; PG8_SCHED;
            PG8_LDA(At, 1, 1); PG8_STAGE(PG8_SB(1, 0), b3, voffB); PG8_STAGE(PG8_SB(1, 1), b3 + hstep, voffB); PG8_STAGE(PG8_SA(1, 0), a3, voffA);
            PG8_WAIT_V(8); PG8_WAIT_L(0); PG8_BAR; PG8_MMA(1, 0, At, B0); PG8_MMA(1, 1, At, B1); PG8_BAR; PG8_SCHED;
            } else {
            PG8_LDB(B0, 0, 0); PG8_SCHED; PG8_LDA(At, 0, 0); PG8_STAGE(PG8_SA(1, 1), a1 + hstep, voffA);
            PG8_WAIT_L(8); PG8_BAR; PG8_WAIT_L(0); PG8_MMA(0, 0, At, B0); PG8_BAR; PG8_SCHED;
            PG8_LDB(B1, 0, 1); PG8_STAGE(PG8_SB(0, 0), b2, voffB);
            PG8_BAR; PG8_WAIT_L(0); PG8_MMA(0, 1, At, B1); PG8_BAR;
            PG8_LDA(At, 0, 1); PG8_STAGE(PG8_SA(0, 0), a2, voffA);
            PG8_BAR; PG8_WAIT_L(0); PG8_MMA(1, 0, At, B0); PG8_BAR; PG8_SCHED;
            PG8_STAGE(PG8_SB(0, 1), b2 + hstep, voffB);
            PG8_WAIT_V(6); PG8_BAR; PG8_MMA(1, 1, At, B1); PG8_BAR;
            PG8_LDB(B0, 1, 0); PG8_SCHED; PG8_LDA(At, 1, 0); PG8_STAGE(PG8_SA(0, 1), a2 + hstep, voffA);
            PG8_WAIT_L(8); PG8_BAR; PG8_WAIT_L(0); PG8_MMA(0, 0, At, B0); PG8_BAR; PG8_SCHED;
            PG8_LDB(B1, 1, 1); PG8_STAGE(PG8_SB(1, 0), b3, voffB);
            PG8_BAR; PG8_WAIT_L(0); PG8_MMA(0, 1, At, B1); PG8_BAR;
            PG8_LDA(At, 1, 1); PG8_STAGE(PG8_SA(1, 0), a3, voffA);
            PG8_BAR; PG8_WAIT_L(0); PG8_MMA(1, 0, At, B0); PG8_BAR; PG8_SCHED;
            PG8_STAGE(PG8_SB(1, 1), b3 + hstep, voffB);
            PG8_WAIT_V(6); PG8_BAR; PG8_MMA(1, 1, At, B1); PG8_BAR;
            }
        }
        if constexpr (ALIGN_EPI) { if (wr == 0) PG8_BAR; }
        if constexpr (!Epi::AFTER_DRAIN) { E(acc, cur, wr, wc, fr, fq); S.done(cur); }
        if (!has_next) break;
#pragma unroll
        for (int a = 0; a < 2; ++a)
#pragma unroll
            for (int b = 0; b < 2; ++b)
#pragma unroll
                for (int m = 0; m < 4; ++m)
#pragma unroll
                    for (int n = 0; n < 2; ++n) acc[a][b][m][n] = (f32x4){0.f, 0.f, 0.f, 0.f};
        cur = nxt; cA = nA; cB = nB; ++ui;
        if constexpr (ALIGN_EPI) { if (wr == 1) PG8_BAR; }
    }
    PG8_WAIT_V(0);
    if constexpr (!ALIGN_EPI) { if (wr == 0) PG8_BAR; }
    PG8_BAR;
    if constexpr (Epi::AFTER_DRAIN) { E.fused(acc, cur, wr, wc, fr, fq, lds, wid, lane); S.done(cur); }
#undef PG8_SA
#undef PG8_SB
#undef PG8_STAGE
#undef PG8_LDA
#undef PG8_LDB
#undef PG8_MMA
#undef PG8_WAIT_V
#undef PG8_WAIT_L
#undef PG8_BAR
#undef PG8_SCHED
}
}

constexpr int NWAVES = 8;
#ifndef MK_N_LAUNCHES
#define MK_N_LAUNCHES 1
#endif
constexpr int PER_PHASE = 8;
constexpr int N_LAUNCHES = MK_N_LAUNCHES;

constexpr int BATCH = 16, SEQ = 2048, D = 1024, M = BATCH * SEQ, NH = 8, DFF = 2816, INC = 7168;
constexpr float RMS_EPS = 1e-6f, LN_EPS = 1e-5f;

constexpr size_t MiB = 1u << 20;
constexpr size_t WS_CTL = 0, CTL_ZERO_BYTES = 1 * MiB;
constexpr size_t WS_WIN = 2 * MiB;
constexpr size_t WS_WCA = 16 * MiB;
constexpr size_t WS_WO = 20 * MiB;
constexpr size_t WS_WGU = 22 * MiB;
constexpr size_t WS_WD = 33 * MiB;
constexpr size_t WS_ROPE = 40 * MiB;
constexpr size_t WS_RS1 = 40 * MiB + 256 * 1024;
constexpr size_t WS_PART1 = 41 * MiB, WS_PART2 = 43 * MiB;
constexpr size_t WS_XB = 48 * MiB;
constexpr size_t WS_U = 112 * MiB;
constexpr size_t WS_CA = 176 * MiB;
constexpr size_t WS_V = 304 * MiB;
constexpr size_t WS_K = 368 * MiB;
constexpr size_t WS_END = 432 * MiB;
constexpr size_t WS_MERGED = WS_XB, WS_X1B = WS_U, WS_FF = WS_CA;
static_assert(WS_WD + (size_t)D * DFF * 2 <= WS_ROPE && WS_FF + (size_t)M * DFF * 2 <= WS_K && WS_PART2 + (size_t)M * 64 <= WS_XB, "d_ws map");
constexpr int CW_TMO = 0, CW_CODE = 1;
constexpr int CW_BAR = 4096;

constexpr int RING_OFF = 0, RING_BYTES = 131072;
constexpr int LDSCTL_OFF = RING_BYTES, MISC_OFF = LDSCTL_OFF + 320;
constexpr int LDS_BYTES = 147456;
static_assert(MISC_OFF + 128 <= LDS_BYTES, "LDS map");
#define GAS __attribute__((address_space(1)))
#define LAS __attribute__((address_space(3)))
typedef unsigned short bf16;
typedef unsigned v4u __attribute__((ext_vector_type(4)));
typedef float f32x4 __attribute__((ext_vector_type(4)));
typedef short bf16x8 __attribute__((ext_vector_type(8)));
typedef GAS unsigned gu32;
typedef GAS unsigned long long gu64;
#define RLX_AGENT __ATOMIC_RELAXED, __HIP_MEMORY_SCOPE_AGENT
#define LDS_WAIT() asm volatile("s_waitcnt lgkmcnt(0)" ::: "memory")
#define VM_WAIT() asm volatile("s_waitcnt vmcnt(0)" ::: "memory")
__device__ __forceinline__ unsigned long long rt() { return __builtin_amdgcn_s_memrealtime(); }
__device__ __forceinline__ unsigned f2bf(float f) { unsigned u = __builtin_bit_cast(unsigned, f); return (u + 0x7fffu + ((u >> 16) & 1u)) >> 16; }
__device__ __forceinline__ unsigned pk2(float lo, float hi) { return f2bf(lo) | (f2bf(hi) << 16); }

#define XB_TMO      128
#define XB_XCNT(j)  (256  + 64 * (j))
#define XB_XSUB(j)  (1280 + 64 * (j))
#define XB_XGEN(j)  (2304 + 64 * (j))
#define XB_TOP      3328
#define XB_TOPGEN   3392
#define XCD_BAR_WORDS 3456
#define XB_SPIN_CAP (1u << 18)

__device__ __forceinline__ unsigned xb_ld(unsigned* p)              { return __hip_atomic_load(p, __ATOMIC_RELAXED, __HIP_MEMORY_SCOPE_AGENT); }
__device__ __forceinline__ unsigned xb_add(unsigned* p, unsigned v) { return __hip_atomic_fetch_add(p, v, __ATOMIC_RELAXED, __HIP_MEMORY_SCOPE_AGENT); }
__device__ __forceinline__ unsigned xb_xcc_id() { return (unsigned)__builtin_amdgcn_s_getreg((3 << 11) | 20) & 0xFu; }
#define XB_SPIN(cond, bar) do { unsigned _sp = 0; while (cond) { __builtin_amdgcn_s_sleep(1); \
    if ((++_sp & 255u) == 0u) { if (xb_ld(&(bar)[XB_TMO])) break; if (_sp > XB_SPIN_CAP) { atomicAdd(&(bar)[XB_TMO], 1u); break; } } } } while (0)

struct XcdBarrier {
    unsigned* bar; unsigned x;
    volatile LAS unsigned* st;
};

__device__ __forceinline__ XcdBarrier xcd_barrier_post(unsigned* bar, volatile LAS unsigned* st) {
    XcdBarrier b; b.bar = bar; b.x = xb_xcc_id(); b.st = st;
    if (threadIdx.x == 0) (void)xb_add(&bar[XB_XCNT(b.x)], 1u);
    return b;
}
__device__ __forceinline__ void xcd_barrier_complete(unsigned* bar, unsigned x, unsigned& nloc, unsigned& nx) {
    const unsigned G = gridDim.x * gridDim.y * gridDim.z;
    unsigned sum, cnt, mine, sp = 0u;
    for (;;) {
        sum = 0u; cnt = 0u; mine = 0u;
#pragma unroll
        for (unsigned j = 0; j < 16; ++j) { const unsigned c = xb_ld(&bar[XB_XCNT(j)]); sum += c; cnt += (c > 0u) ? 1u : 0u; mine = (j == x) ? c : mine; }
        if (sum == G) break;
        __builtin_amdgcn_s_sleep(1);
        if ((++sp & 255u) == 0u) { if (xb_ld(&bar[XB_TMO])) break; if (sp > XB_SPIN_CAP) { atomicAdd(&bar[XB_TMO], 1u); break; } }
    }
    nloc = mine > 0u ? mine : 1u; nx = cnt > 0u ? cnt : 1u;
}

__device__ __forceinline__ void xcd_barrier(const XcdBarrier& b) {
    asm volatile("s_waitcnt vmcnt(0)" ::: "memory");
    __syncthreads();
    if (threadIdx.x == 0) {
        unsigned* bar = b.bar;
        __builtin_amdgcn_s_waitcnt(0);
        unsigned nloc = b.st[0], nx = b.st[1];
        if (nloc == 0u) { xcd_barrier_complete(bar, b.x, nloc, nx); b.st[0] = nloc; b.st[1] = nx; }
        const unsigned old = xb_add(&bar[XB_XSUB(b.x)], 1u);
        const unsigned gen = old / nloc;
        if (old + 1u == (gen + 1u) * nloc) {
            __builtin_amdgcn_fence(__ATOMIC_RELEASE, "agent");
            asm volatile("s_waitcnt vmcnt(0)" ::: "memory");
            const unsigned og = xb_add(&bar[XB_TOP], 1u);
            const unsigned tg = og / nx;
            if (og + 1u == (tg + 1u) * nx) xb_add(&bar[XB_TOPGEN], 1u);
            else XB_SPIN(xb_ld(&bar[XB_TOPGEN]) == tg, bar);
            __builtin_amdgcn_fence(__ATOMIC_ACQUIRE, "agent");
            xb_add(&bar[XB_XGEN(b.x)], 1u);
            asm volatile("s_waitcnt vmcnt(0)" ::: "memory");
        } else {
            XB_SPIN(xb_ld(&bar[XB_XGEN(b.x)]) == gen, bar);
            __builtin_amdgcn_fence(__ATOMIC_ACQUIRE, "agent");
            asm volatile("s_waitcnt vmcnt(0)" ::: "memory");
        }
    }
    __syncthreads();
}

struct Frame {
    LAS unsigned char* lds;
    volatile LAS unsigned* MISC;
    gu32* ctl;
    int tid, lane, wave;
    int vcu, G;
};

__device__ __forceinline__ float wave_sum(float v) {
#pragma unroll
    for (int o = 1; o < 64; o <<= 1) v += __shfl_xor(v, o);
    return v;
}

__device__ __forceinline__ int map_in(int n) {
    if (n < 1024) return ((n >> 7) << 8) + (n & 127);
    if (n < 2048) { const int c = n - 1024; return ((c >> 7) << 8) + 128 + (c & 127); }
    if (n < 4096) { const int d = n & 63; const int dp = d < 16 ? (2 * (d & 7) + (d >> 3)) : d; return n - d + dp; }
    if (n < 5120) return n;
    if (n < 6144) { const int c = n - 5120; return 5120 + ((c >> 7) << 8) + (c & 127); }
    { const int c = n - 6144; return 5120 + ((c >> 7) << 8) + 128 + (c & 127); }
}
template <int MAP> __device__ __forceinline__ int maprow(int n) {
    if (MAP == 1) return map_in(n);
    if (MAP == 2) return ((n >> 7) << 8) + (n & 127);
    if (MAP == 3) return ((n >> 7) << 8) + 128 + (n & 127);
    return n;
}
template <int MAP> __device__ __forceinline__ void p0_transpose_item(const float* W, int K, int N, bf16* WT, int ldt, int koff, const float* g, LAS float* scr, int item, int lane) {
    const int nblk = N / 32, kb = item / nblk, nb = item % nblk, k0 = 64 * kb, n0 = 32 * nb;
#pragma unroll 8
    for (int i = 0; i < 32; ++i) { const int kk = 2 * i + (lane >> 5); const float sc = g ? g[k0 + kk] : 1.f; scr[kk * 33 + (lane & 31)] = W[(size_t)(k0 + kk) * N + n0 + (lane & 31)] * sc; }
    LDS_WAIT(); asm volatile("" ::: "memory");
    const int c = lane & 7;
#pragma unroll
    for (int j = 0; j < 4; ++j) { const int n = (lane >> 3) + 8 * j; const LAS float* s = scr + (8 * c) * 33 + n;
        v4u o; o.x = pk2(s[0 * 33], s[1 * 33]); o.y = pk2(s[2 * 33], s[3 * 33]); o.z = pk2(s[4 * 33], s[5 * 33]); o.w = pk2(s[6 * 33], s[7 * 33]);
        *(GAS v4u*)(WT + (size_t)maprow<MAP>(n0 + n) * ldt + koff + k0 + 8 * c) = o; }
    LDS_WAIT(); asm volatile("" ::: "memory");
}
__device__ __forceinline__ void p0_row(const float* xrow, bf16* orow, float* rs, int lane) {
    const GAS f32x4* xr = (const GAS f32x4*)xrow + lane;
    f32x4 v[4]; float s = 0.f;
#pragma unroll
    for (int j = 0; j < 4; ++j) { v[j] = xr[64 * j]; s += (v[j].x * v[j].x + v[j].y * v[j].y) + (v[j].z * v[j].z + v[j].w * v[j].w); }
    const float r = 1.f / sqrtf(wave_sum(s) * (1.f / D) + RMS_EPS);
    if (lane == 0) *rs = r;
    GAS unsigned long long* o8 = (GAS unsigned long long*)orow + lane;
#pragma unroll
    for (int j = 0; j < 4; ++j) o8[64 * j] = (unsigned long long)pk2(v[j].x, v[j].y) | ((unsigned long long)pk2(v[j].z, v[j].w) << 32);
}
__device__ __forceinline__ void rope_entry(int e, float* rope) {
    const int pos = e >> 3, i = e & 7;
    const float invf = i == 0 ? 1.0f : i == 1 ? 0.1939227432012558f : i == 2 ? 0.03760603070259094f : i == 3 ? 0.007292664609849453f : i == 4 ? 0.0014142135623842478f
                     : i == 5 ? 0.00027424818836152554f : i == 6 ? 5.3182957344688475e-05f : 1.0313385246263351e-05f;
    const float angf = (float)pos * invf; const double a = (double)angf;
    const double kq = __builtin_rint(a * 0.63661977236758134308);
    double r = __builtin_fma(-kq, 1.57079632679489655800, a); r = __builtin_fma(-kq, 6.12323399573676603587e-17, r);
    const double r2 = r * r;
    double sp = -7.6471637318198164759e-13; sp = sp * r2 + 1.6059043836821614599e-10; sp = sp * r2 - 2.5052108385441718775e-08; sp = sp * r2 + 2.7557319223985890653e-06;
    sp = sp * r2 - 1.9841269841269841270e-04; sp = sp * r2 + 8.3333333333333333333e-03; sp = sp * r2 - 1.6666666666666666667e-01; const double sn = r + r * r2 * sp;
    double cp = 4.7794773323873852974e-14; cp = cp * r2 - 1.1470745597729724714e-11; cp = cp * r2 + 2.0876756987868098979e-09; cp = cp * r2 - 2.7557319223985890653e-07;
    cp = cp * r2 + 2.4801587301587301587e-05; cp = cp * r2 - 1.3888888888888888889e-03; cp = cp * r2 + 4.1666666666666666667e-02; cp = cp * r2 - 0.5; const double cs = 1.0 + r2 * cp;
    const int q = (int)((long long)kq & 3);
    const double c = q == 0 ? cs : q == 1 ? -sn : q == 2 ? -cs : sn, s = q == 0 ? sn : q == 1 ? cs : q == 2 ? -sn : -cs;
    rope[2 * e] = (float)c; rope[2 * e + 1] = (float)s;
}
struct P0Args { const float *x, *g_mix, *w_in, *w_cpw, *w_apw, *w_out, *g_ffn, *w_fg, *w_fu, *w_fd; bf16 *WIN, *WCA, *WO, *WGU, *WD, *XB; float *rs1, *rope; };
__device__ __forceinline__ void p0_prologue(Frame& F, const P0Args& a) {
    LAS float* scr = (LAS float*)(F.lds + RING_OFF + F.wave * 16384);
    const int gw = F.vcu * NWAVES + F.wave, NGW = F.G * NWAVES;
    constexpr int I_IN = (D / 64) * (INC / 32), I_SQ = (D / 64) * (D / 32), I_GU = (D / 64) * (DFF / 32), I_DN = (DFF / 64) * (D / 32);
    constexpr int NITEMS = I_IN + 3 * I_SQ + 2 * I_GU + I_DN;
    for (int it = gw; it < NITEMS; it += NGW) {
        int r = it;
        if (r < I_IN) { p0_transpose_item<1>(a.w_in, D, INC, a.WIN, D, 0, a.g_mix, scr, r, F.lane); continue; } r -= I_IN;
        if (r < I_SQ) { p0_transpose_item<0>(a.w_cpw, D, D, a.WCA, 2 * D, 0, nullptr, scr, r, F.lane); continue; } r -= I_SQ;
        if (r < I_SQ) { p0_transpose_item<0>(a.w_apw, D, D, a.WCA, 2 * D, D, nullptr, scr, r, F.lane); continue; } r -= I_SQ;
        if (r < I_SQ) { p0_transpose_item<0>(a.w_out, D, D, a.WO, D, 0, nullptr, scr, r, F.lane); continue; } r -= I_SQ;
        if (r < I_GU) { p0_transpose_item<2>(a.w_fg, D, DFF, a.WGU, D, 0, a.g_ffn, scr, r, F.lane); continue; } r -= I_GU;
        if (r < I_GU) { p0_transpose_item<3>(a.w_fu, D, DFF, a.WGU, D, 0, a.g_ffn, scr, r, F.lane); continue; } r -= I_GU;
        p0_transpose_item<0>(a.w_fd, DFF, D, a.WD, DFF, 0, nullptr, scr, r, F.lane);
    }
    for (int m = gw; m < M; m += NGW) p0_row(a.x + (size_t)m * D, a.XB + (size_t)m * D, a.rs1 + m, F.lane);
    for (int e = (F.vcu * NWAVES + F.wave) * 64 + F.lane; e < SEQ * 8; e += F.G * NWAVES * 64) rope_entry(e, a.rope);
}

struct ConvArgs { const bf16* U; bf16* CA; const float *wdw, *bdw, *gln, *bln; };
typedef float f32x2 __attribute__((ext_vector_type(2)));
template <int I> struct ConvLoop {
    static __device__ __forceinline__ void run(f32x2 (&acc)[32], const f32x2 (&w)[31], const bf16* up, bool head) {
        unsigned uv = 0u;
        if (I >= 30 || !head) uv = *(const unsigned*)(up + (size_t)I * D);
        const f32x2 u2 = {__uint_as_float(uv << 16), __uint_as_float(uv & 0xffff0000u)};
        constexpr int OLO = I > 30 ? I - 30 : 0, OHI = I < 31 ? I : 31;
#pragma unroll
        for (int o = OLO; o <= OHI; ++o) acc[o] += w[I - o] * u2;
        ConvLoop<I + 1>::run(acc, w, up, head);
    }
};
template <> struct ConvLoop<62> { static __device__ __forceinline__ void run(f32x2 (&)[32], const f32x2 (&)[31], const bf16*, bool) {} };
__device__ __forceinline__ void conv_item(Frame& F, const ConvArgs& a, int item) {
    const int tid = F.tid, lane = F.lane, c0 = 2 * tid, row0 = item * 32, t0 = row0 & (SEQ - 1);
    f32x2 w[31];
#pragma unroll
    for (int j = 0; j < 31; ++j) w[j] = *(const f32x2*)(a.wdw + j * D + c0);
    f32x2 acc[32];
#pragma unroll
    for (int o = 0; o < 32; ++o) acc[o] = (f32x2){0.f, 0.f};
    const bool head = (t0 == 0);
    ConvLoop<0>::run(acc, w, a.U + ((size_t)row0 - 30) * D + c0, head);
    const f32x2 bd = *(const f32x2*)(a.bdw + c0);
    float v[64];
#pragma unroll
    for (int o = 0; o < 32; ++o) { acc[o] += bd; v[o] = acc[o].x + acc[o].y; v[32 + o] = acc[o].x * acc[o].x + acc[o].y * acc[o].y; }
#define TR_STEP(OFF) { const bool up_ = (lane & (OFF)) != 0; _Pragma("unroll") for (int k = 0; k < (OFF); ++k) { const float send = up_ ? v[k] : v[k + (OFF)], keep = up_ ? v[k + (OFF)] : v[k]; v[k] = keep + __shfl_xor(send, (OFF)); } }
    TR_STEP(32) TR_STEP(16) TR_STEP(8) TR_STEP(4) TR_STEP(2) TR_STEP(1)
#undef TR_STEP
    LAS float* red = (LAS float*)(F.lds + RING_OFF);
    LAS float* stat = red + 512;
    red[F.wave * 64 + lane] = v[0];
    __syncthreads();
    if (tid < 64) { float s = 0.f;
#pragma unroll
        for (int wv = 0; wv < 8; ++wv) s += red[wv * 64 + tid];
        stat[tid] = s; }
    __syncthreads();
    const f32x2 gl = *(const f32x2*)(a.gln + c0), bl = *(const f32x2*)(a.bln + c0);
    bf16* op = a.CA + (size_t)row0 * 2048 + c0;
#pragma unroll
    for (int o = 0; o < 32; ++o) { const float mean = stat[o] * (1.f / D), var = stat[32 + o] * (1.f / D) - mean * mean, rstd = 1.f / sqrtf(fmaxf(var, 0.f) + LN_EPS);
        const float y0 = (acc[o].x - mean) * rstd * gl.x + bl.x, y1 = (acc[o].y - mean) * rstd * gl.y + bl.y;
        *(unsigned*)(op + (size_t)o * 2048) = pg8::cvt_pk_bf16(y0 * pg8::sigm(y0), y1 * pg8::sigm(y1)); }
    __syncthreads();
}

namespace att {
typedef short bf16x8 __attribute__((ext_vector_type(8)));
typedef short s16x4 __attribute__((ext_vector_type(4)));
typedef float f32x16 __attribute__((ext_vector_type(16)));
typedef short v4i16_t __attribute__((ext_vector_type(4)));
__device__ __forceinline__ int crow(int r, int hi) { return (r & 3) + 8 * (r >> 2) + 4 * hi; }
__device__ __forceinline__ s16x4 vtr(const LAS unsigned char* p) { return __builtin_bit_cast(s16x4, __builtin_amdgcn_ds_read_tr16_b64_v4i16((LAS v4i16_t*)p)); }
#define ATT_MFMA(a, b, c) __builtin_amdgcn_mfma_f32_32x32x16_bf16(a, b, c, 0, 0, 0)
__device__ __forceinline__ void attn_unit(int b, int h, int qb, bf16* CA, const bf16* Kp, const bf16* Vp, const float* gsub, float lam, LAS unsigned char* lds) {
    const int tid = threadIdx.x, lane = tid & 63, r32 = lane & 31, hi = lane >> 5;
    const int wid = __builtin_amdgcn_readfirstlane(tid >> 6), comp = wid >> 2, w4 = wid & 3;
    const int q0 = qb * 128, NT = 2 * qb + 2;
    const size_t rowbase = (size_t)b * SEQ;
    LAS float* wsf = (LAS float*)(lds + 65536) + wid * 32;
    const bf16* Qp = CA + (rowbase + q0 + w4 * 32 + r32) * 2048 + 1024 + h * 128 + comp * 64 + hi * 8;
    bf16x8 qr[4];
#pragma unroll
    for (int d0 = 0; d0 < 4; ++d0) qr[d0] = *(const bf16x8*)(Qp + d0 * 16);
    const unsigned char* Kt = (const unsigned char*)(Kp + (size_t)((b * 8 + h) * 32) * 8192) + tid * 16;
    const unsigned char* Vt = (const unsigned char*)(Vp + (size_t)((b * 8 + h) * 32) * 8192) + tid * 16;
    v4u ks0 = *(const v4u*)(Kt), ks1 = *(const v4u*)(Kt + 8192), vs0 = *(const v4u*)(Vt), vs1 = *(const v4u*)(Vt + 8192);
    { LAS unsigned char* d = lds + tid * 16; *(LAS v4u*)(d) = ks0; *(LAS v4u*)(d + 8192) = ks1; *(LAS v4u*)(d + 16384) = vs0; *(LAS v4u*)(d + 24576) = vs1; }
    __syncthreads();
    f32x16 o[4];
#pragma unroll
    for (int d = 0; d < 4; ++d)
#pragma unroll
        for (int r = 0; r < 16; ++r) o[d][r] = 0.f;
    float mref = -1e30f, l = 0.f;
    const int qrel = w4 * 32 + r32;
    for (int t = 0; t < NT; ++t) {
        const int buf = t & 1; const bool more = (t + 1 < NT);
        if (more) { const size_t go = (size_t)(t + 1) * 16384; ks0 = *(const v4u*)(Kt + go); ks1 = *(const v4u*)(Kt + go + 8192); vs0 = *(const v4u*)(Vt + go); vs1 = *(const v4u*)(Vt + go + 8192); }
        const int jb = t - (NT - 2);
        const bool skip = (jb == 1) && (w4 < 2);
        if (!skip) {
            const LAS unsigned char* kb = lds + buf * 32768 + comp * 8192 + hi * 1024 + r32 * 16;
            f32x16 p0, p1;
#pragma unroll
            for (int r = 0; r < 16; ++r) { p0[r] = 0.f; p1[r] = 0.f; }
#pragma unroll
            for (int d0 = 0; d0 < 4; ++d0) { const bf16x8 a0 = *(const LAS bf16x8*)(kb + d0 * 2048), a1 = *(const LAS bf16x8*)(kb + d0 * 2048 + 512);
                p0 = ATT_MFMA(a0, qr[d0], p0); p1 = ATT_MFMA(a1, qr[d0], p1); }
            if (jb >= 0) { const int kb_ = 64 * jb + 4 * hi;
#pragma unroll
                for (int r = 0; r < 16; ++r) { const int kv = kb_ + (r & 3) + 8 * (r >> 2); if (kv > qrel) p0[r] = -INFINITY; if (kv + 32 > qrel) p1[r] = -INFINITY; } }
            float rm = fmaxf(p0[0], p1[0]);
#pragma unroll
            for (int r = 1; r < 16; ++r) rm = fmaxf(rm, fmaxf(p0[r], p1[r]));
            rm = fmaxf(rm, __shfl_xor(rm, 32));
            if (__any(rm > mref + 8.f)) {
                const float mnew = fmaxf(mref, rm), f = pg8::ex2(mref - mnew); mref = mnew; l *= f;
                if (hi == 0) wsf[r32] = f;
#pragma unroll
                for (int r = 0; r < 16; ++r) { const float fr_ = wsf[crow(r, hi)];
#pragma unroll
                    for (int d = 0; d < 4; ++d) o[d][r] *= fr_; }
            }
            float sacc = 0.f;
#pragma unroll
            for (int r = 0; r < 16; ++r) { p0[r] = pg8::ex2(p0[r] - mref); p1[r] = pg8::ex2(p1[r] - mref); sacc += p0[r] + p1[r]; }
            l += sacc;
            v4u pw[4];
#pragma unroll
            for (int k = 0; k < 2; ++k) {
                pw[k] = (v4u){pg8::cvt_pk_bf16(p0[8 * k], p0[8 * k + 1]), pg8::cvt_pk_bf16(p0[8 * k + 2], p0[8 * k + 3]), pg8::cvt_pk_bf16(p0[8 * k + 4], p0[8 * k + 5]), pg8::cvt_pk_bf16(p0[8 * k + 6], p0[8 * k + 7])};
                pw[2 + k] = (v4u){pg8::cvt_pk_bf16(p1[8 * k], p1[8 * k + 1]), pg8::cvt_pk_bf16(p1[8 * k + 2], p1[8 * k + 3]), pg8::cvt_pk_bf16(p1[8 * k + 4], p1[8 * k + 5]), pg8::cvt_pk_bf16(p1[8 * k + 6], p1[8 * k + 7])}; }
            const LAS unsigned char* vb = lds + buf * 32768 + 16384 + (4 * hi + ((lane & 15) >> 2)) * 64 + ((lane >> 4) & 1) * 32 + (lane & 3) * 8;
#pragma unroll
            for (int d = 0; d < 4; ++d)
#pragma unroll
                for (int k = 0; k < 4; ++k) { const s16x4 lo = vtr(vb + (d * 4 + k) * 1024), hh = vtr(vb + (d * 4 + k) * 1024 + 512);
                    const bf16x8 vf = {lo[0], lo[1], lo[2], lo[3], hh[0], hh[1], hh[2], hh[3]};
                    o[d] = ATT_MFMA(__builtin_bit_cast(bf16x8, pw[k]), vf, o[d]); }
        }
        if (more) { LAS unsigned char* d = lds + (buf ^ 1) * 32768 + tid * 16; *(LAS v4u*)(d) = ks0; *(LAS v4u*)(d + 8192) = ks1; *(LAS v4u*)(d + 16384) = vs0; *(LAS v4u*)(d + 24576) = vs1; }
        __syncthreads();
    }
    l += __shfl_xor(l, 32);
    { float inv = 1.f / l; if (comp == 1) inv *= lam; if (hi == 0) wsf[r32] = inv; }
#pragma unroll
    for (int r = 0; r < 16; ++r) { const float ri = wsf[crow(r, hi)];
#pragma unroll
        for (int d = 0; d < 4; ++d) o[d][r] *= ri; }
    LAS f32x4* X = (LAS f32x4*)lds;
    if (comp == 1) {
#pragma unroll
        for (int d = 0; d < 4; ++d)
#pragma unroll
            for (int rq = 0; rq < 4; ++rq) X[((w4 * 4 + d) * 4 + rq) * 64 + lane] = (f32x4){o[d][4 * rq], o[d][4 * rq + 1], o[d][4 * rq + 2], o[d][4 * rq + 3]};
    }
    __syncthreads();
    if (comp == 0) {
        float ss[16];
#pragma unroll
        for (int r = 0; r < 16; ++r) ss[r] = 0.f;
#pragma unroll
        for (int d = 0; d < 4; ++d)
#pragma unroll
            for (int rq = 0; rq < 4; ++rq) { const f32x4 x = X[((w4 * 4 + d) * 4 + rq) * 64 + lane];
#pragma unroll
                for (int e = 0; e < 4; ++e) { const float y = o[d][4 * rq + e] - x[e]; o[d][4 * rq + e] = y; ss[4 * rq + e] += y * y; } }
#pragma unroll
        for (int r = 0; r < 16; ++r) {
#pragma unroll
            for (int off = 1; off < 32; off <<= 1) ss[r] += __shfl_xor(ss[r], off);
            ss[r] = 1.f / sqrtf(ss[r] * (1.f / 128.f) + RMS_EPS); }
        float gs[4];
#pragma unroll
        for (int d = 0; d < 4; ++d) gs[d] = gsub[32 * d + r32] * 0.8f;
        bf16* Op = CA + (rowbase + q0 + w4 * 32) * 2048 + 1024 + h * 128 + r32;
#pragma unroll
        for (int r = 0; r < 16; ++r) { bf16* rp = Op + (size_t)crow(r, hi) * 2048;
#pragma unroll
            for (int d = 0; d < 4; ++d) rp[32 * d] = (bf16)f2bf(o[d][r] * ss[r] * gs[d]); }
    }
    __syncthreads();
}
#undef ATT_MFMA
}

__device__ __forceinline__ void final_rows(Frame& F, float* out, const float* part, const float* gfin) {
    const int gw = F.vcu * NWAVES + F.wave, NGW = F.G * NWAVES;
    f32x4 g[4];
#pragma unroll
    for (int j = 0; j < 4; ++j) g[j] = *((const GAS f32x4*)gfin + F.lane + 64 * j);
    for (int m = gw; m < M; m += NGW) {
        GAS f32x4* xr = (GAS f32x4*)(out + (size_t)m * D) + F.lane;
        f32x4 v[4];
#pragma unroll
        for (int j = 0; j < 4; ++j) v[j] = xr[64 * j];
        const f32x4 p0 = *(const f32x4*)(part + (size_t)m * 16), p1 = *(const f32x4*)(part + (size_t)m * 16 + 4), p2 = *(const f32x4*)(part + (size_t)m * 16 + 8), p3 = *(const f32x4*)(part + (size_t)m * 16 + 12);
        const float s = (((p0[0] + p0[1]) + (p0[2] + p0[3])) + ((p1[0] + p1[1]) + (p1[2] + p1[3]))) + (((p2[0] + p2[1]) + (p2[2] + p2[3])) + ((p3[0] + p3[1]) + (p3[2] + p3[3])));
        const float rs = 1.f / sqrtf(s * (1.f / D) + RMS_EPS);
#pragma unroll
        for (int j = 0; j < 4; ++j) xr[64 * j] = v[j] * rs * g[j];
    }
}

struct Args { const float* in[21]; float* out; unsigned char* ws; int ph_lo, ph_hi, li, pad; };
__global__ void __launch_bounds__(NWAVES * 64, 2) hyb_fwd(Args args) {
    extern __shared__ __attribute__((aligned(16))) unsigned char lds[];
    Frame F;
    F.lds = (LAS unsigned char*)lds;
    F.MISC = (volatile LAS unsigned*)(F.lds + MISC_OFF);
    F.tid = threadIdx.x; F.lane = F.tid & 63; F.wave = __builtin_amdgcn_readfirstlane(F.tid >> 6);
    F.G = gridDim.x; { const int bx = blockIdx.x; F.vcu = (F.G % 8 == 0) ? (bx % 8) * (F.G / 8) + bx / 8 : bx; }
    unsigned char* ws = args.ws;
    F.ctl = (gu32*)(ws + WS_CTL);
#define IN_(k) (args.in[k])
#define x_ IN_(0)
#define g_mix IN_(1)
#define w_in IN_(2)
#define b_gate IN_(3)
#define w_dw IN_(4)
#define b_dw IN_(5)
#define g_cln IN_(6)
#define b_cln IN_(7)
#define w_cpw IN_(8)
#define lq1 IN_(9)
#define lk1 IN_(10)
#define lq2 IN_(11)
#define lk2 IN_(12)
#define g_sub IN_(13)
#define w_apw IN_(14)
#define w_out IN_(15)
#define g_ffn IN_(16)
#define w_fg IN_(17)
#define w_fu IN_(18)
#define w_fd IN_(19)
#define g_fin IN_(20)
#define out (args.out)
#define WIN ((bf16*)(ws + WS_WIN))
#define WCA ((bf16*)(ws + WS_WCA))
#define WO ((bf16*)(ws + WS_WO))
#define WGU ((bf16*)(ws + WS_WGU))
#define WD ((bf16*)(ws + WS_WD))
#define ROPE ((float*)(ws + WS_ROPE))
#define RS1 ((float*)(ws + WS_RS1))
#define PART1 ((float*)(ws + WS_PART1))
#define PART2 ((float*)(ws + WS_PART2))
#define XB ((bf16*)(ws + WS_XB))
#define U ((bf16*)(ws + WS_U))
#define CA ((bf16*)(ws + WS_CA))
#define VP ((bf16*)(ws + WS_V))
#define KP ((bf16*)(ws + WS_K))
#define MERGED ((bf16*)(ws + WS_MERGED))
#define X1B ((bf16*)(ws + WS_X1B))
#define FF ((bf16*)(ws + WS_FF))
#define GATES ((bf16*)out)

    for (int u = F.tid; u < (LDS_BYTES - LDSCTL_OFF) / 4; u += NWAVES * 64) ((LAS unsigned*)(F.lds + LDSCTL_OFF))[u] = 0u;
    __syncthreads();
    XcdBarrier bar; bar.bar = (unsigned*)(F.ctl + CW_BAR); bar.x = 0; bar.st = nullptr;
    if (N_LAUNCHES != PER_PHASE) bar = xcd_barrier_post((unsigned*)(F.ctl + CW_BAR), F.MISC + 8);
#define GRID_BAR() do { if (N_LAUNCHES != PER_PHASE) xcd_barrier(bar); } while (0)
    const int lo = args.ph_lo, hi = args.ph_hi;
#ifndef PH_MASK
#define PH_MASK 0xff
#endif
#define IN(k) (((PH_MASK >> (k)) & 1) && lo <= (k) && (k) < hi)
#define BOTH(k) (IN(k) && IN((k) + 1))

    if (IN(0)) {
        P0Args a{x_, g_mix, w_in, w_cpw, w_apw, w_out, g_ffn, w_fg, w_fu, w_fd, WIN, WCA, WO, WGU, WD, XB, RS1, ROPE};
        p0_prologue(F, a);
        if (BOTH(0)) GRID_BAR();
    }
    if (IN(1)) {
        pg8::Gemm g{XB, WIN, M, INC, D}; pg8::StaticOrder S; S.init(M, INC, F.G, (int)blockIdx.x);
        pg8::EpiIn E{U, CA, KP, VP, GATES, RS1, b_gate, ROPE};
        pg8::gemm_phase<pg8::EpiIn, pg8::StaticOrder, true, true>(F.lds + RING_OFF, g, S, E);
        if (BOTH(1)) GRID_BAR();
    }
    if (IN(2)) {
#ifndef NO_CONV
        { ConvArgs ca{U, CA, w_dw, b_dw, g_cln, b_cln};
          for (int it = F.vcu * 4; it < M / 32; it += F.G * 4) for (int k = 0; k < 4; ++k) conv_item(F, ca, it + k); }
#endif
#ifndef NO_ATTN
        const float d1 = wave_sum(lq1[F.lane] * lk1[F.lane]), d2 = wave_sum(lq2[F.lane] * lk2[F.lane]);
        const float lam = expf(d1) - expf(d2) + 0.2f;
        for (int v = F.vcu; v < 256; v += F.G) {
            const int bh = v >> 1, sub = v & 1;
            for (int i = 0; i < 8; ++i) { const int k = i >> 1; const int qb = (i & 1) ? (2 * k + sub) : (15 - 2 * k - sub);
                att::attn_unit(bh >> 3, bh & 7, qb, CA, KP, VP, g_sub, lam, F.lds + RING_OFF); }
        }
#endif
        if (BOTH(2)) GRID_BAR();
    }
    if (IN(3)) {
        pg8::Gemm g{CA, WCA, M, D, 2 * D}; pg8::StaticOrder S; S.init(M, D, F.G, (int)blockIdx.x);
        pg8::EpiMerge E{GATES, MERGED};
        pg8::gemm_phase<pg8::EpiMerge, pg8::StaticOrder, true, true>(F.lds + RING_OFF, g, S, E);
        if (BOTH(3)) GRID_BAR();
    }
    if (IN(4)) {
        pg8::Gemm g{MERGED, WO, M, D, D}; pg8::StaticOrder S; S.init(M, D, F.G, (int)blockIdx.x);
        pg8::EpiResid E{x_, out, X1B, PART1};
        pg8::gemm_phase<pg8::EpiResid, pg8::StaticOrder, true, true>(F.lds + RING_OFF, g, S, E);
        if (BOTH(4)) GRID_BAR();
    }
    if (IN(5)) {
        pg8::Gemm g{X1B, WGU, M, 2 * DFF, D}; pg8::StaticOrder S; S.init(M, 2 * DFF, F.G, (int)blockIdx.x);
        pg8::EpiUp E{PART1, FF, DFF};
        pg8::gemm_phase<pg8::EpiUp, pg8::StaticOrder, true, true>(F.lds + RING_OFF, g, S, E);
        if (BOTH(5)) GRID_BAR();
    }
    if (IN(6)) {
        pg8::Gemm g{FF, WD, M, D, DFF}; pg8::StaticOrder S; S.init(M, D, F.G, (int)blockIdx.x);
        pg8::EpiResid E{out, out, nullptr, PART2};
        pg8::gemm_phase<pg8::EpiResid, pg8::StaticOrder, true, true>(F.lds + RING_OFF, g, S, E);
        if (BOTH(6)) GRID_BAR();
    }
    if (IN(7)) final_rows(F, out, PART2, g_fin);
#undef IN
#undef BOTH
#undef GRID_BAR
#undef IN_
#undef x_
#undef g_mix
#undef w_in
#undef b_gate
#undef w_dw
#undef b_dw
#undef g_cln
#undef b_cln
#undef w_cpw
#undef lq1
#undef lk1
#undef lq2
#undef lk2
#undef g_sub
#undef w_apw
#undef w_out
#undef g_ffn
#undef w_fg
#undef w_fu
#undef w_fd
#undef g_fin
#undef out
#undef WIN
#undef WCA
#undef WO
#undef WGU
#undef WD
#undef ROPE
#undef RS1
#undef PART1
#undef PART2
#undef XB
#undef U
#undef CA
#undef VP
#undef KP
#undef MERGED
#undef X1B
#undef FF
#undef GATES
}

extern "C" void kernel_launch(void* const* d_in, const int* in_sizes, int n_in, void* d_out, int out_size, void* d_ws, size_t ws_size, hipStream_t stream) {
    static int grid = 0;
    if (grid == 0) {
        if (n_in != 21 || in_sizes[0] != M * D || out_size != M * D || ws_size < WS_END) { fprintf(stderr, "kernel_launch: unexpected problem: n_in %d in0 %d out %d ws %zu; nothing launched\n", n_in, n_in > 0 ? in_sizes[0] : -1, out_size, ws_size); grid = -1; return; }
        int dev = 0, cus = 0, per_cu = 0;
        if (hipGetDevice(&dev) != hipSuccess || hipDeviceGetAttribute(&cus, hipDeviceAttributeMultiprocessorCount, dev) != hipSuccess) { fprintf(stderr, "kernel_launch: device query failed\n"); grid = -1; return; }
        if (hipFuncSetAttribute((const void*)hyb_fwd, hipFuncAttributeMaxDynamicSharedMemorySize, LDS_BYTES) != hipSuccess) { fprintf(stderr, "kernel_launch: hipFuncSetAttribute failed\n"); grid = -1; return; }
        if (hipOccupancyMaxActiveBlocksPerMultiprocessor(&per_cu, (const void*)hyb_fwd, NWAVES * 64, LDS_BYTES) != hipSuccess || per_cu < 1)
            fprintf(stderr, "kernel_launch: note: occupancy query reports %d workgroups per CU\n", per_cu);
        (void)hipGetLastError();
        grid = cus;
        if (grid > 256) grid = 256;
    }
    if (grid < 0) return;
    if (hipMemsetAsync((char*)d_ws + WS_CTL, 0, CTL_ZERO_BYTES, stream) != hipSuccess) { fprintf(stderr, "kernel_launch: hipMemsetAsync failed\n"); return; }
    Args a{};
    for (int i = 0; i < 21; ++i) a.in[i] = (const float*)d_in[i];
    a.out = (float*)d_out; a.ws = (unsigned char*)d_ws;
    if (N_LAUNCHES == 1) { a.ph_lo = 0; a.ph_hi = PER_PHASE; a.li = 0; hipLaunchKernelGGL(hyb_fwd, dim3(grid), dim3(NWAVES * 64), LDS_BYTES, stream, a); }
    else for (int li = 0; li < PER_PHASE; ++li) { a.ph_lo = li; a.ph_hi = li + 1; a.li = li; hipLaunchKernelGGL(hyb_fwd, dim3(grid), dim3(NWAVES * 64), LDS_BYTES, stream, a); }
    const hipError_t le = hipPeekAtLastError();
    if (le != hipSuccess) fprintf(stderr, "kernel_launch: launch failed: %s\n", hipGetErrorName(le));
}
```

```cpp
#include <hip/hip_runtime.h>
#include <cstdio>
#include <cstdint>
namespace pg8 {
#define PG8_LAS __attribute__((address_space(3)))
typedef unsigned short bf16_t;
typedef short bf16x8 __attribute__((ext_vector_type(8)));
typedef float f32x4 __attribute__((ext_vector_type(4)));
typedef unsigned u32x4 __attribute__((ext_vector_type(4)));
constexpr int BM = 256, BK = 64, HALF = 128, HTB = HALF * BK * 2  , STAGE_BYTES = 8 * HTB, NXCD = 8, WGM = 8;

__host__ __device__ __forceinline__ int lds_byte(int r, int c) { const int st = (r >> 4) * 2 + (c >> 5), rr = r & 15, cc = c & 31, ob = rr * 64 + cc * 2; return st * 1024 + (ob ^ (((ob >> 9) & 1) << 5)); }
__host__ __device__ __forceinline__ void stage_rc(int b, int& R, int& C) { const int st = b / 1024, sb = b % 1024, swz = sb ^ (((sb >> 9) & 1) << 5); R = (st >> 1) * 16 + swz / 64; C = (st & 1) * 32 + (swz % 64) / 2; }
__host__ __device__ __forceinline__ int perm32(int rho) { const int n = rho >> 4, i = rho & 15; return 8 * (i >> 2) + 4 * n + (i & 3); }

struct Unit { int pm, pn; };
struct Gemm { const bf16_t* A; const bf16_t* Bt; int M, N, K; };

struct StaticOrder {
    int nM, nN, nwg, G, c;
    __host__ __device__ void init(int M, int N, int G_, int c_) { nM = M / BM; nN = N / BM; nwg = nM * nN; G = G_; c = c_; }
    __host__ __device__ bool next(int i, Unit& u) const {
        const long L = (long)i * G + c; if (L >= nwg) return false;
        int wgid = (int)L; { const int q = nwg / NXCD, r = nwg % NXCD, xcd = wgid % NXCD, off = wgid / NXCD; wgid = (xcd < r ? xcd * (q + 1) : r * (q + 1) + (xcd - r) * q) + off; }
        const int nig = WGM * nN, gid = wgid / nig, fm = gid * WGM, gsz = (nM - fm) < WGM ? (nM - fm) : WGM;
        u.pm = fm + ((wgid % nig) % gsz); u.pn = (wgid % nig) / gsz; return true;
    }
    __device__ __forceinline__ void a_ready(const Unit&) const {}
    __device__ __forceinline__ void done(const Unit&) const {}
};

__device__ __forceinline__ unsigned cvt_pk_bf16(float lo, float hi) { unsigned r; asm volatile("v_cvt_pk_bf16_f32 %0, %1, %2" : "=v"(r) : "v"(lo), "v"(hi)); return r; }
__device__ __forceinline__ float bf_lo(unsigned w) { return __uint_as_float(w << 16); }
__device__ __forceinline__ float bf_hi(unsigned w) { return __uint_as_float(w & 0xffff0000u); }
constexpr float LOG2E = 1.4426950408889634f;
__device__ __forceinline__ float ex2(float x) { return __builtin_amdgcn_exp2f(x); }
__device__ __forceinline__ float rcpf_(float x) { return __builtin_amdgcn_rcpf(x); }
__device__ __forceinline__ float sigm(float x) { return rcpf_(1.f + ex2(-x * LOG2E)); }
__device__ __forceinline__ u32x4 pack8(const f32x4 a, const f32x4 b) { u32x4 w; w.x = cvt_pk_bf16(a[0], a[1]); w.y = cvt_pk_bf16(a[2], a[3]); w.z = cvt_pk_bf16(b[0], b[1]); w.w = cvt_pk_bf16(b[2], b[3]); return w; }

constexpr int SEQ_ = 2048;
constexpr float QSCALE = 0.125f * 1.4426950408889634f;

struct EpiIn {
    static constexpr bool PERM = true, AFTER_DRAIN = false, MID = false;
    bf16_t* U; bf16_t* CA; bf16_t* Kp; bf16_t* Vp; bf16_t* G; const float* rs1; const float* bgate; const float* rope;
    __device__ __forceinline__ void operator()(const f32x4 (&acc)[2][2][4][2], const Unit& u, int wr, int wc, int fr, int fq) const {
        const int pn = u.pn, rowb = u.pm * BM + wr * 64 + fr;
        if (pn < 8) {
            bf16_t* base = U + pn * 128 + wc * 32 + fq * 8;
#pragma unroll
            for (int ai = 0; ai < 2; ++ai)
#pragma unroll
                for (int m = 0; m < 4; ++m) { const int r = rowb + ai * HALF + m * 16; const float rs = rs1[r]; f32x4 o[2];
#pragma unroll
                    for (int n = 0; n < 2; ++n) { const f32x4 a = acc[ai][0][m][n] * rs, g = acc[ai][1][m][n] * rs;
#pragma unroll
                        for (int e = 0; e < 4; ++e) o[n][e] = a[e] * sigm(g[e]); }
                    *(u32x4*)(base + (size_t)r * 1024) = pack8(o[0], o[1]); }
        } else if (pn < 16) {
            const bool isq = pn < 12; const bool dorope = ((wc & 1) == 0) && (fq < 2);
#pragma unroll
            for (int ai = 0; ai < 2; ++ai)
#pragma unroll
                for (int m = 0; m < 4; ++m) { const int r = rowb + ai * HALF + m * 16; const float rs = rs1[r]; const int pos = r & (SEQ_ - 1);
                    f32x4 cs0 = {1.f, 0.f, 1.f, 0.f}, cs1 = {1.f, 0.f, 1.f, 0.f};
                    if (dorope) { const float* rp = rope + ((size_t)pos * 8 + 4 * fq) * 2; cs0 = *(const f32x4*)rp; cs1 = *(const f32x4*)(rp + 4); }
#pragma unroll
                    for (int bj = 0; bj < 2; ++bj) { f32x4 v0 = acc[ai][bj][m][0] * rs, v1 = acc[ai][bj][m][1] * rs;
                        { const float a = v0[0], b = v0[1], c = v0[2], d = v0[3];
                          v0[0] = a * cs0[0] - b * cs0[1]; v0[1] = b * cs0[0] + a * cs0[1]; v0[2] = c * cs0[2] - d * cs0[3]; v0[3] = d * cs0[2] + c * cs0[3]; }
                        { const float a = v1[0], b = v1[1], c = v1[2], d = v1[3];
                          v1[0] = a * cs1[0] - b * cs1[1]; v1[1] = b * cs1[0] + a * cs1[1]; v1[2] = c * cs1[2] - d * cs1[3]; v1[3] = d * cs1[2] + c * cs1[3]; }
                        if (isq) { v0 = v0 * QSCALE; v1 = v1 * QSCALE;
                            *(u32x4*)(CA + (size_t)r * 2048 + 1024 + (pn - 8) * 256 + bj * HALF + wc * 32 + fq * 8) = pack8(v0, v1);
                        } else { const int b_ = r >> 11, tile = pos >> 6, row = pos & 63, h = 2 * (pn - 12) + bj, comp = wc >> 1, chunk = 4 * (wc & 1) + fq;
                            *(u32x4*)(Kp + ((size_t)((((b_ * 8 + h) * 32 + tile) * 2 + comp) * 8 + chunk) * 64 + row) * 8) = pack8(v0, v1); } } }
        } else if (pn < 20) {
#pragma unroll
            for (int ai = 0; ai < 2; ++ai)
#pragma unroll
                for (int m = 0; m < 4; ++m) { const int r = rowb + ai * HALF + m * 16; const float rs = rs1[r]; const int pos = r & (SEQ_ - 1), b_ = r >> 11, tile = pos >> 6, ks = (pos & 63) >> 4, r16 = pos & 15;
#pragma unroll
                    for (int bj = 0; bj < 2; ++bj) { const int h = 2 * (pn - 16) + bj; const f32x4 v0 = acc[ai][bj][m][0] * rs, v1 = acc[ai][bj][m][1] * rs;
                        *(u32x4*)(Vp + ((size_t)(((b_ * 8 + h) * 32 + tile) * 16 + wc * 4 + ks) * 16 + r16) * 32 + fq * 8) = pack8(v0, v1); } }
        } else {
            const int ch = (pn - 20) * 128 + wc * 32 + fq * 8;
            const f32x4 bc0 = *(const f32x4*)(bgate + ch), bc1 = *(const f32x4*)(bgate + ch + 4), ba0 = *(const f32x4*)(bgate + 1024 + ch), ba1 = *(const f32x4*)(bgate + 1024 + ch + 4);
#pragma unroll
            for (int ai = 0; ai < 2; ++ai)
#pragma unroll
                for (int m = 0; m < 4; ++m) { const int r = rowb + ai * HALF + m * 16; const float rs = rs1[r]; f32x4 rt[2], ga[2];
#pragma unroll
                    for (int n = 0; n < 2; ++n) { const f32x4 xc = acc[ai][0][m][n] * rs + (n ? bc1 : bc0), xa = acc[ai][1][m][n] * rs + (n ? ba1 : ba0);
#pragma unroll
                        for (int e = 0; e < 4; ++e) { const float ea = ex2(fminf(-xa[e] * LOG2E, 80.f)), ec = ex2(-xc[e] * LOG2E); ga[n][e] = rcpf_(1.f + ea); rt[n][e] = (1.f + ea) * rcpf_(1.f + ec); } }
                    *(u32x4*)(G + (size_t)r * 2048 + ch) = pack8(rt[0], rt[1]);
                    *(u32x4*)(G + (size_t)r * 2048 + 1024 + ch) = pack8(ga[0], ga[1]); }
        }
    }
};

struct EpiMerge {
    static constexpr bool PERM = true, AFTER_DRAIN = false, MID = true;
    const bf16_t* G; bf16_t* O;
    __device__ __forceinline__ void mid(f32x4 (&acc)[2][2][4][2], const Unit& u, int wr, int wc, int fr, int fq) const {
        asm volatile("" : "+v"(fr), "+v"(fq));
        const int rowb = u.pm * BM + wr * 64 + fr, col = u.pn * BM + wc * 32 + fq * 8;
#pragma unroll
        for (int ai = 0; ai < 2; ++ai)
#pragma unroll
            for (int m = 0; m < 4; ++m) { const bf16_t* gp = G + (size_t)(rowb + ai * HALF + m * 16) * 2048 + col;
#pragma unroll
                for (int bj = 0; bj < 2; ++bj) { const u32x4 w = *(const u32x4*)(gp + bj * HALF);
                    acc[ai][bj][m][0] *= (f32x4){bf_lo(w.x), bf_hi(w.x), bf_lo(w.y), bf_hi(w.y)}; acc[ai][bj][m][1] *= (f32x4){bf_lo(w.z), bf_hi(w.z), bf_lo(w.w), bf_hi(w.w)}; }
                if (m & 1) asm volatile("" ::: "memory"); }
    }
    __device__ __forceinline__ void operator()(const f32x4 (&acc)[2][2][4][2], const Unit& u, int wr, int wc, int fr, int fq) const {
        const int rowb = u.pm * BM + wr * 64 + fr, col = u.pn * BM + wc * 32 + fq * 8;
#pragma unroll
        for (int ai = 0; ai < 2; ++ai)
#pragma unroll
            for (int m = 0; m < 4; ++m) { const int r = rowb + ai * HALF + m * 16; const bf16_t* gp = G + (size_t)r * 2048 + 1024 + col;
#pragma unroll
                for (int bj = 0; bj < 2; ++bj) { const u32x4 w = *(const u32x4*)(gp + bj * HALF);
                    const f32x4 v0 = acc[ai][bj][m][0] * (f32x4){bf_lo(w.x), bf_hi(w.x), bf_lo(w.y), bf_hi(w.y)}, v1 = acc[ai][bj][m][1] * (f32x4){bf_lo(w.z), bf_hi(w.z), bf_lo(w.w), bf_hi(w.w)};
                    *(u32x4*)(O + (size_t)r * 1024 + col + bj * HALF) = pack8(v0, v1); } }
    }
};

struct EpiResidB {
    static constexpr bool PERM = true, AFTER_DRAIN = false, MID = false;
    const bf16_t* base; bf16_t* ob; float* part;
    __device__ __forceinline__ void operator()(const f32x4 (&acc)[2][2][4][2], const Unit& u, int wr, int wc, int fr, int fq) const {
        const int rowb = u.pm * BM + wr * 64 + fr, col0 = u.pn * BM + wc * 32 + 8 * fq;
#pragma unroll
        for (int ai = 0; ai < 2; ++ai)
#pragma unroll
            for (int m = 0; m < 4; ++m) { const int r = rowb + ai * HALF + m * 16; const size_t off = (size_t)r * 1024 + col0; float ss = 0.f;
#pragma unroll
                for (int bj = 0; bj < 2; ++bj) { const u32x4 w = *(const u32x4*)(base + off + bj * HALF);
                    const f32x4 v0 = acc[ai][bj][m][0] + (f32x4){bf_lo(w.x), bf_hi(w.x), bf_lo(w.y), bf_hi(w.y)}, v1 = acc[ai][bj][m][1] + (f32x4){bf_lo(w.z), bf_hi(w.z), bf_lo(w.w), bf_hi(w.w)};
                    ss += ((v0[0] * v0[0] + v0[1] * v0[1]) + (v0[2] * v0[2] + v0[3] * v0[3])) + ((v1[0] * v1[0] + v1[1] * v1[1]) + (v1[2] * v1[2] + v1[3] * v1[3]));
                    *(u32x4*)(ob + off + bj * HALF) = pack8(v0, v1); }
                ss += __shfl_xor(ss, 16); ss += __shfl_xor(ss, 32);
                if (fq == 0) part[(size_t)r * 16 + u.pn * 4 + wc] = ss; }
    }
};
struct EpiResidF {
    static constexpr bool PERM = true, AFTER_DRAIN = false, MID = false;
    const bf16_t* base; float* out; float* part;
    __device__ __forceinline__ void operator()(const f32x4 (&acc)[2][2][4][2], const Unit& u, int wr, int wc, int fr, int fq) const {
        const int rowb = u.pm * BM + wr * 64 + fr, col0 = u.pn * BM + wc * 32 + 8 * fq;
#pragma unroll
        for (int ai = 0; ai < 2; ++ai)
#pragma unroll
            for (int m = 0; m < 4; ++m) { const int r = rowb + ai * HALF + m * 16; const size_t off = (size_t)r * 1024 + col0; float ss = 0.f;
#pragma unroll
                for (int bj = 0; bj < 2; ++bj) { const u32x4 w = *(const u32x4*)(base + off + bj * HALF);
                    const f32x4 v0 = acc[ai][bj][m][0] + (f32x4){bf_lo(w.x), bf_hi(w.x), bf_lo(w.y), bf_hi(w.y)}, v1 = acc[ai][bj][m][1] + (f32x4){bf_lo(w.z), bf_hi(w.z), bf_lo(w.w), bf_hi(w.w)};
                    ss += ((v0[0] * v0[0] + v0[1] * v0[1]) + (v0[2] * v0[2] + v0[3] * v0[3])) + ((v1[0] * v1[0] + v1[1] * v1[1]) + (v1[2] * v1[2] + v1[3] * v1[3]));
                    *(f32x4*)(out + off + bj * HALF) = v0; *(f32x4*)(out + off + bj * HALF + 4) = v1; }
                ss += __shfl_xor(ss, 16); ss += __shfl_xor(ss, 32);
                if (fq == 0) part[(size_t)r * 16 + u.pn * 4 + wc] = ss; }
    }
};

struct EpiUp {
    static constexpr bool PERM = true, AFTER_DRAIN = false, MID = false;
    const float* part; bf16_t* FF; int ldf;
    __device__ __forceinline__ void operator()(const f32x4 (&acc)[2][2][4][2], const Unit& u, int wr, int wc, int fr, int fq) const {
        const int rowb = u.pm * BM + wr * 64 + fr; bf16_t* base = FF + u.pn * 128 + wc * 32 + fq * 8;
#pragma unroll
        for (int ai = 0; ai < 2; ++ai)
#pragma unroll
            for (int m = 0; m < 4; ++m) { const int r = rowb + ai * HALF + m * 16; const f32x4 pv = *(const f32x4*)(part + (size_t)r * 16 + 4 * fq);
                float s = (pv[0] + pv[1]) + (pv[2] + pv[3]); s += __shfl_xor(s, 16); s += __shfl_xor(s, 32);
                const float rs = 1.0f / sqrtf(s * (1.0f / 1024.0f) + 1e-6f); f32x4 o[2];
#pragma unroll
                for (int n = 0; n < 2; ++n) { const f32x4 g = acc[ai][0][m][n] * rs, up = acc[ai][1][m][n] * rs;
#pragma unroll
                    for (int e = 0; e < 4; ++e) o[n][e] = g[e] * sigm(g[e]) * up[e]; }
                *(u32x4*)(base + (size_t)r * ldf) = pack8(o[0], o[1]); }
    }
};

template <class Epi, class Sched, bool ALIGN_EPI = false, bool SP2 = false>
__device__ __forceinline__ void gemm_phase(PG8_LAS unsigned char* lds, const Gemm g, const Sched& S, const Epi& E) {
    const int tid = threadIdx.x, wid = __builtin_amdgcn_readfirstlane(tid >> 6), lane = tid & 63, wr = wid >> 2, wc = wid & 3, fr = lane & 15, fq = lane >> 4;
    const int K = g.K, nt = K / BK;
    unsigned voffA[2], voffB[2];
#pragma unroll
    for (int i = 0; i < 2; ++i) { int R, C; stage_rc(tid * 16 + i * 8192, R, C); const int Rb = Epi::PERM ? ((R & ~31) + perm32(R & 31)) : R;
        voffA[i] = (unsigned)(R * K + C) * 2u; voffB[i] = (unsigned)(Rb * K + C) * 2u; }
    const size_t kstep = (size_t)(BK * 2);
    const size_t hstep = (size_t)HALF * K * 2;
    const size_t tstep = 2 * hstep;
    const unsigned ldsw = (unsigned)wid * 1024u;
    const int aoff = lds_byte(wr * 64 + fr, fq * 8), boff = lds_byte(wc * 32 + fr, fq * 8);
#define PG8_SA(b, h) (((b) * 2 + (h)) * HTB)
#define PG8_SB(b, h) ((4 + (b) * 2 + (h)) * HTB)
#define PG8_STAGE(bufoff, gbase, voff) do { _Pragma("unroll") for (int _i = 0; _i < 2; ++_i) \
        __builtin_amdgcn_global_load_lds((const unsigned*)((const char*)(gbase) + (voff)[_i]), (PG8_LAS unsigned*)(lds + (bufoff) + ldsw + _i * 8192), 16, 0, 0); } while (0)
#define PG8_LDA(dst, b, h) do { _Pragma("unroll") for (int m = 0; m < 4; ++m) _Pragma("unroll") for (int k = 0; k < 2; ++k) dst[m][k] = *(const PG8_LAS bf16x8*)(lds + PG8_SA(b, h) + aoff + m * 2048 + k * 1024); } while (0)
#define PG8_LDB(dst, b, h) do { _Pragma("unroll") for (int n = 0; n < 2; ++n) _Pragma("unroll") for (int k = 0; k < 2; ++k) dst[n][k] = *(const PG8_LAS bf16x8*)(lds + PG8_SB(b, h) + boff + n * 2048 + k * 1024); } while (0)
#define PG8_MMA(ai, bj, At, Bt) do { __builtin_amdgcn_s_setprio(1); _Pragma("unroll") for (int m = 0; m < 4; ++m) _Pragma("unroll") for (int n = 0; n < 2; ++n) _Pragma("unroll") for (int k = 0; k < 2; ++k) \
        acc[ai][bj][m][n] = __builtin_amdgcn_mfma_f32_16x16x32_bf16(Bt[n][k], At[m][k], acc[ai][bj][m][n], 0, 0, 0); __builtin_amdgcn_s_setprio(0); } while (0)
#define PG8_WAIT_V(n) asm volatile("s_waitcnt vmcnt(" #n ")" ::: "memory")
#define PG8_WAIT_L(n) asm volatile("s_waitcnt lgkmcnt(" #n ")" ::: "memory")
#define PG8_BAR __builtin_amdgcn_s_barrier()
#define PG8_SCHED __builtin_amdgcn_sched_barrier(0)
    Unit cur, nxt; int ui = 0;
    if (!S.next(0, cur)) return;
    f32x4 acc[2][2][4][2];
#pragma unroll
    for (int a = 0; a < 2; ++a)
#pragma unroll
        for (int b = 0; b < 2; ++b)
#pragma unroll
            for (int m = 0; m < 4; ++m)
#pragma unroll
                for (int n = 0; n < 2; ++n) acc[a][b][m][n] = (f32x4){0.f, 0.f, 0.f, 0.f};
    bf16x8 At[4][2], B0[2][2], B1[2][2];
    const char* cA = (const char*)g.A + (size_t)cur.pm * tstep; const char* cB = (const char*)g.Bt + (size_t)cur.pn * tstep;
    S.a_ready(cur);
    if constexpr (SP2) {
        PG8_STAGE(PG8_SB(0, 0), cB, voffB); PG8_STAGE(PG8_SB(0, 1), cB + hstep, voffB); PG8_STAGE(PG8_SA(0, 0), cA, voffA); PG8_STAGE(PG8_SA(0, 1), cA + hstep, voffA);
        if (wr == 1) PG8_BAR;
        PG8_WAIT_V(2); PG8_BAR;
        PG8_STAGE(PG8_SB(1, 0), cB + kstep, voffB); PG8_STAGE(PG8_SA(1, 0), cA + kstep, voffA); PG8_STAGE(PG8_SB(1, 1), cB + hstep + kstep, voffB);
        PG8_WAIT_V(6); PG8_BAR;
    } else {
        PG8_STAGE(PG8_SB(0, 0), cB, voffB); PG8_STAGE(PG8_SA(0, 0), cA, voffA); PG8_STAGE(PG8_SB(0, 1), cB + hstep, voffB); PG8_STAGE(PG8_SA(0, 1), cA + hstep, voffA);
        if (wr == 1) PG8_BAR;
        PG8_WAIT_V(4); PG8_BAR;
        PG8_STAGE(PG8_SB(1, 0), cB + kstep, voffB); PG8_STAGE(PG8_SA(1, 0), cA + kstep, voffA); PG8_STAGE(PG8_SB(1, 1), cB + hstep + kstep, voffB);
        PG8_WAIT_V(6); PG8_BAR;
    }
    for (;;) {
        const bool has_next = S.next(ui + 1, nxt);
        const char* nA = has_next ? (const char*)g.A + (size_t)nxt.pm * tstep : cA; const char* nB = has_next ? (const char*)g.Bt + (size_t)nxt.pn * tstep : cB;
        for (int t = 0; t < nt; t += 2) {
            if constexpr (Epi::MID) { if (t == (nt >> 1)) E.mid(acc, cur, wr, wc, fr, fq); }
            const bool last = (t == nt - 2);
            const char* a1 = cA + (size_t)(t + 1) * kstep;
            const char* a2 = last ? nA : cA + (size_t)(t + 2) * kstep; const char* b2 = last ? nB : cB + (size_t)(t + 2) * kstep;
            const char* a3 = a2 + kstep; const char* b3 = b2 + kstep;
            if (last && has_next) S.a_ready(nxt);
            if constexpr (SP2) {
            PG8_LDB(B0, 0, 0); PG8_LDB(B1, 0, 1); PG8_SCHED; PG8_LDA(At, 0, 0); PG8_STAGE(PG8_SA(1, 1), a1 + hstep, voffA);
            PG8_WAIT_V(8); PG8_WAIT_L(0); PG8_BAR; PG8_MMA(0, 0, At, B0); PG8_MMA(0, 1, At, B1); PG8_BAR; PG8_SCHED;
            PG8_LDA(At, 0, 1); PG8_STAGE(PG8_SB(0, 0), b2, voffB); PG8_STAGE(PG8_SB(0, 1), b2 + hstep, voffB); PG8_STAGE(PG8_SA(0, 0), a2, voffA);
            PG8_WAIT_V(8); PG8_WAIT_L(0); PG8_BAR; PG8_MMA(1, 0, At, B0); PG8_MMA(1, 1, At, B1); PG8_BAR; PG8_SCHED;
            PG8_LDB(B0, 1, 0); PG8_LDB(B1, 1, 1); PG8_SCHED; PG8_LDA(At, 1, 0); PG8_STAGE(PG8_SA(0, 1), a2 + hstep, voffA);
            PG8_WAIT_V(8); PG8_WAIT_L(0); PG8_BAR; PG8_MMA(0, 0, At, B0); PG8_MMA(0, 1, At, B1); PG8_BAR; PG8_SCHED;
            PG8_LDA(At, 1, 1); PG8_STAGE(PG8_SB(1, 0), b3, voffB); PG8_STAGE(PG8_SB(1, 1), b3 + hstep, voffB); PG8_STAGE(PG8_SA(1, 0), a3, voffA);
            PG8_WAIT_V(8); PG8_WAIT_L(0); PG8_BAR; PG8_MMA(1, 0, At, B0); PG8_MMA(1, 1, At, B1); PG8_BAR; PG8_SCHED;
            } else {
            PG8_LDB(B0, 0, 0); PG8_SCHED; PG8_LDA(At, 0, 0); PG8_STAGE(PG8_SA(1, 1), a1 + hstep, voffA);
            PG8_WAIT_L(8); PG8_BAR; PG8_WAIT_L(0); PG8_MMA(0, 0, At, B0); PG8_BAR; PG8_SCHED;
            PG8_LDB(B1, 0, 1); PG8_STAGE(PG8_SB(0, 0), b2, voffB);
            PG8_BAR; PG8_WAIT_L(0); PG8_MMA(0, 1, At, B1); PG8_BAR;
            PG8_LDA(At, 0, 1); PG8_STAGE(PG8_SA(0, 0), a2, voffA);
            PG8_BAR; PG8_WAIT_L(0); PG8_MMA(1, 0, At, B0); PG8_BAR; PG8_SCHED;
            PG8_STAGE(PG8_SB(0, 1), b2 + hstep, voffB);
            PG8_WAIT_V(6); PG8_BAR; PG8_MMA(1, 1, At, B1); PG8_BAR;
            PG8_LDB(B0, 1, 0); PG8_SCHED; PG8_LDA(At, 1, 0); PG8_STAGE(PG8_SA(0, 1), a2 + hstep, voffA);
            PG8_WAIT_L(8); PG8_BAR; PG8_WAIT_L(0); PG8_MMA(0, 0, At, B0); PG8_BAR; PG8_SCHED;
            PG8_LDB(B1, 1, 1); PG8_STAGE(PG8_SB(1, 0), b3, voffB);
            PG8_BAR; PG8_WAIT_L(0); PG8_MMA(0, 1, At, B1); PG8_BAR;
            PG8_LDA(At, 1, 1); PG8_STAGE(PG8_SA(1, 0), a3, voffA);
            PG8_BAR; PG8_WAIT_L(0); PG8_MMA(1, 0, At, B0); PG8_BAR; PG8_SCHED;
            PG8_STAGE(PG8_SB(1, 1), b3 + hstep, voffB);
            PG8_WAIT_V(6); PG8_BAR; PG8_MMA(1, 1, At, B1); PG8_BAR;
            }
        }
        if constexpr (ALIGN_EPI) { if (wr == 0) PG8_BAR; }
        if constexpr (!Epi::AFTER_DRAIN) { E(acc, cur, wr, wc, fr, fq); S.done(cur); }
        if (!has_next) break;
#pragma unroll
        for (int a = 0; a < 2; ++a)
#pragma unroll
            for (int b = 0; b < 2; ++b)
#pragma unroll
                for (int m = 0; m < 4; ++m)
#pragma unroll
                    for (int n = 0; n < 2; ++n) acc[a][b][m][n] = (f32x4){0.f, 0.f, 0.f, 0.f};
        cur = nxt; cA = nA; cB = nB; ++ui;
        if constexpr (ALIGN_EPI) { if (wr == 1) PG8_BAR; }
    }
    PG8_WAIT_V(0);
    if constexpr (!ALIGN_EPI) { if (wr == 0) PG8_BAR; }
    PG8_BAR;
    if constexpr (Epi::AFTER_DRAIN) { E.fused(acc, cur, wr, wc, fr, fq, lds, wid, lane); S.done(cur); }
#undef PG8_SA
#undef PG8_SB
#undef PG8_STAGE
#undef PG8_LDA
#undef PG8_LDB
#undef PG8_MMA
#undef PG8_WAIT_V
#undef PG8_WAIT_L
#undef PG8_BAR
#undef PG8_SCHED
}
}

constexpr int NWAVES = 8;
#ifndef MK_N_LAUNCHES
#define MK_N_LAUNCHES 1
#endif
constexpr int PER_PHASE = 8;
constexpr int N_LAUNCHES = MK_N_LAUNCHES;

constexpr int BATCH = 16, SEQ = 2048, D = 1024, M = BATCH * SEQ, NH = 8, DFF = 2816, INC = 7168;
constexpr float RMS_EPS = 1e-6f, LN_EPS = 1e-5f;

constexpr size_t MiB = 1u << 20;
constexpr size_t WS_CTL = 0, CTL_ZERO_BYTES = 1 * MiB;
constexpr size_t WS_WIN = 2 * MiB;
constexpr size_t WS_WCA = 16 * MiB;
constexpr size_t WS_WO = 20 * MiB;
constexpr size_t WS_WGU = 22 * MiB;
constexpr size_t WS_WD = 33 * MiB;
constexpr size_t WS_ROPE = 40 * MiB;
constexpr size_t WS_RS1 = 40 * MiB + 256 * 1024;
constexpr size_t WS_PART1 = 41 * MiB, WS_PART2 = 43 * MiB;
constexpr size_t WS_XB = 48 * MiB;
constexpr size_t WS_U = 112 * MiB;
constexpr size_t WS_CA = 176 * MiB;
constexpr size_t WS_V = 304 * MiB;
constexpr size_t WS_K = 368 * MiB;
constexpr size_t WS_MERGED = 432 * MiB;
constexpr size_t WS_END = 496 * MiB;
constexpr size_t WS_X1B = WS_U, WS_FF = WS_CA;
static_assert(WS_WD + (size_t)D * DFF * 2 <= WS_ROPE && WS_FF + (size_t)M * DFF * 2 <= WS_K && WS_PART2 + (size_t)M * 64 <= WS_XB, "d_ws map");
constexpr int CW_TMO = 0, CW_CODE = 1;
constexpr int CW_BAR = 4096;

constexpr int RING_OFF = 0, RING_BYTES = 131072;
constexpr int LDSCTL_OFF = RING_BYTES, MISC_OFF = LDSCTL_OFF + 320;
constexpr int LDS_BYTES = 147456;
static_assert(MISC_OFF + 128 <= LDS_BYTES, "LDS map");
#define GAS __attribute__((address_space(1)))
#define LAS __attribute__((address_space(3)))
typedef unsigned short bf16;
typedef unsigned v4u __attribute__((ext_vector_type(4)));
typedef float f32x4 __attribute__((ext_vector_type(4)));
typedef short bf16x8 __attribute__((ext_vector_type(8)));
typedef GAS unsigned gu32;
typedef GAS unsigned long long gu64;
#define RLX_AGENT __ATOMIC_RELAXED, __HIP_MEMORY_SCOPE_AGENT
#define LDS_WAIT() asm volatile("s_waitcnt lgkmcnt(0)" ::: "memory")
#define VM_WAIT() asm volatile("s_waitcnt vmcnt(0)" ::: "memory")
__device__ __forceinline__ unsigned long long rt() { return __builtin_amdgcn_s_memrealtime(); }
__device__ __forceinline__ unsigned f2bf(float f) { unsigned u = __builtin_bit_cast(unsigned, f); return (u + 0x7fffu + ((u >> 16) & 1u)) >> 16; }
__device__ __forceinline__ unsigned pk2(float lo, float hi) { return f2bf(lo) | (f2bf(hi) << 16); }

#define XB_TMO      128
#define XB_XCNT(j)  (256  + 64 * (j))
#define XB_XSUB(j)  (1280 + 64 * (j))
#define XB_XGEN(j)  (2304 + 64 * (j))
#define XB_TOP      3328
#define XB_TOPGEN   3392
#define XCD_BAR_WORDS 3456
#define XB_SPIN_CAP (1u << 18)

__device__ __forceinline__ unsigned xb_ld(unsigned* p)              { return __hip_atomic_load(p, __ATOMIC_RELAXED, __HIP_MEMORY_SCOPE_AGENT); }
__device__ __forceinline__ unsigned xb_add(unsigned* p, unsigned v) { return __hip_atomic_fetch_add(p, v, __ATOMIC_RELAXED, __HIP_MEMORY_SCOPE_AGENT); }
__device__ __forceinline__ unsigned xb_xcc_id() { return (unsigned)__builtin_amdgcn_s_getreg((3 << 11) | 20) & 0xFu; }
#define XB_SPIN(cond, bar) do { unsigned _sp = 0; while (cond) { __builtin_amdgcn_s_sleep(1); \
    if ((++_sp & 255u) == 0u) { if (xb_ld(&(bar)[XB_TMO])) break; if (_sp > XB_SPIN_CAP) { atomicAdd(&(bar)[XB_TMO], 1u); break; } } } } while (0)

struct XcdBarrier {
    unsigned* bar; unsigned x;
    volatile LAS unsigned* st;
};

__device__ __forceinline__ XcdBarrier xcd_barrier_post(unsigned* bar, volatile LAS unsigned* st) {
    XcdBarrier b; b.bar = bar; b.x = xb_xcc_id(); b.st = st;
    if (threadIdx.x == 0) (void)xb_add(&bar[XB_XCNT(b.x)], 1u);
    return b;
}
__device__ __forceinline__ void xcd_barrier_complete(unsigned* bar, unsigned x, unsigned& nloc, unsigned& nx) {
    const unsigned G = gridDim.x * gridDim.y * gridDim.z;
    unsigned sum, cnt, mine, sp = 0u;
    for (;;) {
        sum = 0u; cnt = 0u; mine = 0u;
#pragma unroll
        for (unsigned j = 0; j < 16; ++j) { const unsigned c = xb_ld(&bar[XB_XCNT(j)]); sum += c; cnt += (c > 0u) ? 1u : 0u; mine = (j == x) ? c : mine; }
        if (sum == G) break;
        __builtin_amdgcn_s_sleep(1);
        if ((++sp & 255u) == 0u) { if (xb_ld(&bar[XB_TMO])) break; if (sp > XB_SPIN_CAP) { atomicAdd(&bar[XB_TMO], 1u); break; } }
    }
    nloc = mine > 0u ? mine : 1u; nx = cnt > 0u ? cnt : 1u;
}

__device__ __forceinline__ void xcd_barrier(const XcdBarrier& b) {
    asm volatile("s_waitcnt vmcnt(0)" ::: "memory");
    __syncthreads();
    if (threadIdx.x == 0) {
        unsigned* bar = b.bar;
        __builtin_amdgcn_s_waitcnt(0);
        unsigned nloc = b.st[0], nx = b.st[1];
        if (nloc == 0u) { xcd_barrier_complete(bar, b.x, nloc, nx); b.st[0] = nloc; b.st[1] = nx; }
        const unsigned old = xb_add(&bar[XB_XSUB(b.x)], 1u);
        const unsigned gen = old / nloc;
        if (old + 1u == (gen + 1u) * nloc) {
            __builtin_amdgcn_fence(__ATOMIC_RELEASE, "agent");
            asm volatile("s_waitcnt vmcnt(0)" ::: "memory");
            const unsigned og = xb_add(&bar[XB_TOP], 1u);
            const unsigned tg = og / nx;
            if (og + 1u == (tg + 1u) * nx) xb_add(&bar[XB_TOPGEN], 1u);
            else XB_SPIN(xb_ld(&bar[XB_TOPGEN]) == tg, bar);
            __builtin_amdgcn_fence(__ATOMIC_ACQUIRE, "agent");
            xb_add(&bar[XB_XGEN(b.x)], 1u);
            asm volatile("s_waitcnt vmcnt(0)" ::: "memory");
        } else {
            XB_SPIN(xb_ld(&bar[XB_XGEN(b.x)]) == gen, bar);
            __builtin_amdgcn_fence(__ATOMIC_ACQUIRE, "agent");
            asm volatile("s_waitcnt vmcnt(0)" ::: "memory");
        }
    }
    __syncthreads();
}

struct Frame {
    LAS unsigned char* lds;
    volatile LAS unsigned* MISC;
    gu32* ctl;
    int tid, lane, wave;
    int vcu, G;
};

__device__ __forceinline__ float wave_sum(float v) {
#pragma unroll
    for (int o = 1; o < 64; o <<= 1) v += __shfl_xor(v, o);
    return v;
}

__device__ __forceinline__ int map_in(int n) {
    if (n < 1024) return ((n >> 7) << 8) + (n & 127);
    if (n < 2048) { const int c = n - 1024; return ((c >> 7) << 8) + 128 + (c & 127); }
    if (n < 4096) { const int d = n & 63; const int dp = d < 16 ? (2 * (d & 7) + (d >> 3)) : d; return n - d + dp; }
    if (n < 5120) return n;
    if (n < 6144) { const int c = n - 5120; return 5120 + ((c >> 7) << 8) + (c & 127); }
    { const int c = n - 6144; return 5120 + ((c >> 7) << 8) + 128 + (c & 127); }
}
template <int MAP> __device__ __forceinline__ int maprow(int n) {
    if (MAP == 1) return map_in(n);
    if (MAP == 2) return ((n >> 7) << 8) + (n & 127);
    if (MAP == 3) return ((n >> 7) << 8) + 128 + (n & 127);
    return n;
}
template <int MAP> __device__ __forceinline__ void p0_transpose_item(const float* W, int K, int N, bf16* WT, int ldt, int koff, const float* g, LAS float* scr, int item, int lane) {
    const int nblk = N / 32, kb = item / nblk, nb = item % nblk, k0 = 64 * kb, n0 = 32 * nb;
    float wv[32];
#pragma unroll
    for (int i = 0; i < 32; ++i) { const int kk = 2 * i + (lane >> 5); wv[i] = W[(size_t)(k0 + kk) * N + n0 + (lane & 31)]; }
    if (g) {
#pragma unroll
        for (int i = 0; i < 32; ++i) wv[i] *= g[k0 + 2 * i + (lane >> 5)]; }
#pragma unroll
    for (int i = 0; i < 32; ++i) { const int kk = 2 * i + (lane >> 5); scr[kk * 33 + (lane & 31)] = wv[i]; }
    LDS_WAIT(); asm volatile("" ::: "memory");
    const int c = lane & 7;
#pragma unroll
    for (int j = 0; j < 4; ++j) { const int n = (lane >> 3) + 8 * j; const LAS float* s = scr + (8 * c) * 33 + n;
        v4u o; o.x = pk2(s[0 * 33], s[1 * 33]); o.y = pk2(s[2 * 33], s[3 * 33]); o.z = pk2(s[4 * 33], s[5 * 33]); o.w = pk2(s[6 * 33], s[7 * 33]);
        *(GAS v4u*)(WT + (size_t)maprow<MAP>(n0 + n) * ldt + koff + k0 + 8 * c) = o; }
    LDS_WAIT(); asm volatile("" ::: "memory");
}
template <int NR> __device__ __forceinline__ void p0_rows(const float* xrow, bf16* orow, float* rs, int lane) {
    f32x4 v[NR][4]; float s[NR];
#pragma unroll
    for (int r = 0; r < NR; ++r)
#pragma unroll
        for (int j = 0; j < 4; ++j) v[r][j] = ((const GAS f32x4*)(xrow + (size_t)r * D) + lane)[64 * j];
#pragma unroll
    for (int r = 0; r < NR; ++r) { s[r] = 0.f;
#pragma unroll
        for (int j = 0; j < 4; ++j) s[r] += (v[r][j].x * v[r][j].x + v[r][j].y * v[r][j].y) + (v[r][j].z * v[r][j].z + v[r][j].w * v[r][j].w);
        s[r] = wave_sum(s[r]); }
#pragma unroll
    for (int r = 0; r < NR; ++r) { if (lane == 0) rs[r] = 1.f / sqrtf(s[r] * (1.f / D) + RMS_EPS);
        GAS unsigned long long* o8 = (GAS unsigned long long*)(orow + (size_t)r * D) + lane;
#pragma unroll
        for (int j = 0; j < 4; ++j) o8[64 * j] = (unsigned long long)pk2(v[r][j].x, v[r][j].y) | ((unsigned long long)pk2(v[r][j].z, v[r][j].w) << 32); }
}
__device__ __forceinline__ void rope_entry(int e, float* rope) {
    const int pos = e >> 3, i = e & 7;
    const float invf = i == 0 ? 1.0f : i == 1 ? 0.1939227432012558f : i == 2 ? 0.03760603070259094f : i == 3 ? 0.007292664609849453f : i == 4 ? 0.0014142135623842478f
                     : i == 5 ? 0.00027424818836152554f : i == 6 ? 5.3182957344688475e-05f : 1.0313385246263351e-05f;
    const float angf = (float)pos * invf; const double a = (double)angf;
    const double kq = __builtin_rint(a * 0.63661977236758134308);
    double r = __builtin_fma(-kq, 1.57079632679489655800, a); r = __builtin_fma(-kq, 6.12323399573676603587e-17, r);
    const double r2 = r * r;
    double sp = -7.6471637318198164759e-13; sp = sp * r2 + 1.6059043836821614599e-10; sp = sp * r2 - 2.5052108385441718775e-08; sp = sp * r2 + 2.7557319223985890653e-06;
    sp = sp * r2 - 1.9841269841269841270e-04; sp = sp * r2 + 8.3333333333333333333e-03; sp = sp * r2 - 1.6666666666666666667e-01; const double sn = r + r * r2 * sp;
    double cp = 4.7794773323873852974e-14; cp = cp * r2 - 1.1470745597729724714e-11; cp = cp * r2 + 2.0876756987868098979e-09; cp = cp * r2 - 2.7557319223985890653e-07;
    cp = cp * r2 + 2.4801587301587301587e-05; cp = cp * r2 - 1.3888888888888888889e-03; cp = cp * r2 + 4.1666666666666666667e-02; cp = cp * r2 - 0.5; const double cs = 1.0 + r2 * cp;
    const int q = (int)((long long)kq & 3);
    const double c = q == 0 ? cs : q == 1 ? -sn : q == 2 ? -cs : sn, s = q == 0 ? sn : q == 1 ? cs : q == 2 ? -sn : -cs;
    rope[2 * e] = (float)c; rope[2 * e + 1] = (float)s;
}
struct P0Args { const float *x, *g_mix, *w_in, *w_cpw, *w_apw, *w_out, *g_ffn, *w_fg, *w_fu, *w_fd; bf16 *WIN, *WCA, *WO, *WGU, *WD, *XB; float *rs1, *rope; };
__device__ __forceinline__ void p0_prologue(Frame& F, const P0Args& a) {
    LAS float* scr = (LAS float*)(F.lds + RING_OFF + F.wave * 16384);
    const int gw = F.vcu * NWAVES + F.wave, NGW = F.G * NWAVES;
    constexpr int I_IN = (D / 64) * (INC / 32), I_SQ = (D / 64) * (D / 32), I_GU = (D / 64) * (DFF / 32), I_DN = (DFF / 64) * (D / 32);
    constexpr int NITEMS = I_IN + 3 * I_SQ + 2 * I_GU + I_DN;
    for (int it = gw; it < NITEMS; it += NGW) {
        int r = it;
        if (r < I_IN) { p0_transpose_item<1>(a.w_in, D, INC, a.WIN, D, 0, a.g_mix, scr, r, F.lane); continue; } r -= I_IN;
        if (r < I_SQ) { p0_transpose_item<0>(a.w_cpw, D, D, a.WCA, 2 * D, 0, nullptr, scr, r, F.lane); continue; } r -= I_SQ;
        if (r < I_SQ) { p0_transpose_item<0>(a.w_apw, D, D, a.WCA, 2 * D, D, nullptr, scr, r, F.lane); continue; } r -= I_SQ;
        if (r < I_SQ) { p0_transpose_item<0>(a.w_out, D, D, a.WO, D, 0, nullptr, scr, r, F.lane); continue; } r -= I_SQ;
        if (r < I_GU) { p0_transpose_item<2>(a.w_fg, D, DFF, a.WGU, D, 0, a.g_ffn, scr, r, F.lane); continue; } r -= I_GU;
        if (r < I_GU) { p0_transpose_item<3>(a.w_fu, D, DFF, a.WGU, D, 0, a.g_ffn, scr, r, F.lane); continue; } r -= I_GU;
        p0_transpose_item<0>(a.w_fd, DFF, D, a.WD, DFF, 0, nullptr, scr, r, F.lane);
    }
    for (int m = gw * 4; m < M; m += NGW * 4) p0_rows<4>(a.x + (size_t)m * D, a.XB + (size_t)m * D, a.rs1 + m, F.lane);
    for (int e = (F.vcu * NWAVES + F.wave) * 64 + F.lane; e < SEQ * 8; e += F.G * NWAVES * 64) rope_entry(e, a.rope);
}

struct ConvArgs { const bf16* U; bf16* CA; const float *wdw, *bdw, *gln, *bln; };
typedef float f32x2 __attribute__((ext_vector_type(2)));
template <int I> struct ConvLoop {
    static __device__ __forceinline__ void run(f32x2 (&acc)[32], const f32x2 (&w)[31], const LAS unsigned char* up, bool head) {
        unsigned uv = 0u;
        if (I >= 30 || !head) uv = *(const LAS unsigned*)(up + I * 2048);
        const f32x2 u2 = {__uint_as_float(uv << 16), __uint_as_float(uv & 0xffff0000u)};
        constexpr int OLO = I > 30 ? I - 30 : 0, OHI = I < 31 ? I : 31;
#pragma unroll
        for (int o = OLO; o <= OHI; ++o) acc[o] += w[I - o] * u2;
        ConvLoop<I + 1>::run(acc, w, up, head);
    }
};
template <> struct ConvLoop<62> { static __device__ __forceinline__ void run(f32x2 (&)[32], const f32x2 (&)[31], const LAS unsigned char*, bool) {} };
constexpr int CONV_TILE_BYTES = 62 * 2048, CONV_RED_OFF = CONV_TILE_BYTES, CONV_STAT_OFF = CONV_RED_OFF + 2048;
static_assert(CONV_STAT_OFF + 256 <= RING_BYTES, "conv LDS map");
__device__ __forceinline__ void conv_item(Frame& F, const ConvArgs& a, int item) {
    const int tid = F.tid, lane = F.lane, c0 = 2 * tid, row0 = item * 32, t0 = row0 & (SEQ - 1);
    const bool head = (t0 == 0);
    { const unsigned char* gsrc = (const unsigned char*)(a.U + ((size_t)row0 - 30) * D) + lane * 16;
      for (int p = head ? 60 + ((F.wave + 4) & 7) : F.wave; p < 124; p += 8)
          __builtin_amdgcn_global_load_lds((const unsigned*)(gsrc + (size_t)p * 1024), (LAS unsigned*)(F.lds + RING_OFF + p * 1024), 16, 0, 0); }
    f32x2 w[31];
#pragma unroll
    for (int j = 0; j < 31; ++j) w[j] = *(const f32x2*)(a.wdw + j * D + c0);
    f32x2 acc[32];
#pragma unroll
    for (int o = 0; o < 32; ++o) acc[o] = (f32x2){0.f, 0.f};
    asm volatile("s_waitcnt vmcnt(0)" ::: "memory");
    __syncthreads();
    ConvLoop<0>::run(acc, w, F.lds + RING_OFF + tid * 4, head);
    const f32x2 bd = *(const f32x2*)(a.bdw + c0);
    float v[64];
#pragma unroll
    for (int o = 0; o < 32; ++o) { acc[o] += bd; v[o] = acc[o].x + acc[o].y; v[32 + o] = acc[o].x * acc[o].x + acc[o].y * acc[o].y; }
#define TR_STEP(OFF) { const bool up_ = (lane & (OFF)) != 0; _Pragma("unroll") for (int k = 0; k < (OFF); ++k) { const float send = up_ ? v[k] : v[k + (OFF)], keep = up_ ? v[k + (OFF)] : v[k]; v[k] = keep + __shfl_xor(send, (OFF)); } }
    TR_STEP(32) TR_STEP(16) TR_STEP(8) TR_STEP(4) TR_STEP(2) TR_STEP(1)
#undef TR_STEP
    LAS float* red = (LAS float*)(F.lds + RING_OFF + CONV_RED_OFF);
    LAS float* stat = (LAS float*)(F.lds + RING_OFF + CONV_STAT_OFF);
    red[F.wave * 64 + lane] = v[0];
    __syncthreads();
    if (tid < 64) { float s = 0.f;
#pragma unroll
        for (int wv = 0; wv < 8; ++wv) s += red[wv * 64 + tid];
        stat[tid] = s; }
    __syncthreads();
    const f32x2 gl = *(const f32x2*)(a.gln + c0), bl = *(const f32x2*)(a.bln + c0);
    bf16* op = a.CA + (size_t)row0 * 2048 + c0;
#pragma unroll
    for (int o = 0; o < 32; ++o) { const float mean = stat[o] * (1.f / D), var = stat[32 + o] * (1.f / D) - mean * mean, rstd = 1.f / sqrtf(fmaxf(var, 0.f) + LN_EPS);
        const float y0 = (acc[o].x - mean) * rstd * gl.x + bl.x, y1 = (acc[o].y - mean) * rstd * gl.y + bl.y;
        *(unsigned*)(op + (size_t)o * 2048) = pg8::cvt_pk_bf16(y0 * pg8::sigm(y0), y1 * pg8::sigm(y1)); }
    __syncthreads();
}

namespace att {
typedef short bf16x8 __attribute__((ext_vector_type(8)));
typedef short s16x4 __attribute__((ext_vector_type(4)));
typedef float f32x16 __attribute__((ext_vector_type(16)));
typedef short v4i16_t __attribute__((ext_vector_type(4)));
__device__ __forceinline__ int crow(int r, int hi) { return (r & 3) + 8 * (r >> 2) + 4 * hi; }
__device__ __forceinline__ s16x4 vtr(const LAS unsigned char* p) { return __builtin_bit_cast(s16x4, __builtin_amdgcn_ds_read_tr16_b64_v4i16((LAS v4i16_t*)p)); }
#define ATT_MFMA(a, b, c) __builtin_amdgcn_mfma_f32_32x32x16_bf16(a, b, c, 0, 0, 0)
__device__ __forceinline__ void attn_unit(int b, int h, int qb, bf16* CA, const bf16* Kp, const bf16* Vp, const float* gsub, float lam, LAS unsigned char* lds) {
    const int tid = threadIdx.x, lane = tid & 63, r32 = lane & 31, hi = lane >> 5;
    const int wid = __builtin_amdgcn_readfirstlane(tid >> 6), comp = wid >> 2, w4 = wid & 3;
    const int q0 = qb * 128, NT = 2 * qb + 2;
    const size_t rowbase = (size_t)b * SEQ;
    LAS float* wsf = (LAS float*)(lds + 65536) + wid * 32;
    const bf16* Qp = CA + (rowbase + q0 + w4 * 32 + r32) * 2048 + 1024 + h * 128 + comp * 64 + hi * 8;
    bf16x8 qr[4];
#pragma unroll
    for (int d0 = 0; d0 < 4; ++d0) qr[d0] = *(const bf16x8*)(Qp + d0 * 16);
    const unsigned char* Kt = (const unsigned char*)(Kp + (size_t)((b * 8 + h) * 32) * 8192) + tid * 16;
    const unsigned char* Vt = (const unsigned char*)(Vp + (size_t)((b * 8 + h) * 32) * 8192) + tid * 16;
    v4u ks0 = *(const v4u*)(Kt), ks1 = *(const v4u*)(Kt + 8192), vs0 = *(const v4u*)(Vt), vs1 = *(const v4u*)(Vt + 8192);
    { LAS unsigned char* d = lds + tid * 16; *(LAS v4u*)(d) = ks0; *(LAS v4u*)(d + 8192) = ks1; *(LAS v4u*)(d + 16384) = vs0; *(LAS v4u*)(d + 24576) = vs1; }
    __syncthreads();
    f32x16 o[4];
#pragma unroll
    for (int d = 0; d < 4; ++d)
#pragma unroll
        for (int r = 0; r < 16; ++r) o[d][r] = 0.f;
    float mref = -1e30f, l = 0.f;
    const int qrel = w4 * 32 + r32;
    for (int t = 0; t < NT; ++t) {
        const int buf = t & 1; const bool more = (t + 1 < NT);
        if (more) { const size_t go = (size_t)(t + 1) * 16384; ks0 = *(const v4u*)(Kt + go); ks1 = *(const v4u*)(Kt + go + 8192); vs0 = *(const v4u*)(Vt + go); vs1 = *(const v4u*)(Vt + go + 8192); }
        const int jb = t - (NT - 2);
        const bool skip = (jb == 1) && (w4 < 2);
        if (!skip) {
            const LAS unsigned char* kb = lds + buf * 32768 + comp * 8192 + hi * 1024 + r32 * 16;
            f32x16 p0, p1;
#pragma unroll
            for (int r = 0; r < 16; ++r) { p0[r] = 0.f; p1[r] = 0.f; }
#pragma unroll
            for (int d0 = 0; d0 < 4; ++d0) { const bf16x8 a0 = *(const LAS bf16x8*)(kb + d0 * 2048), a1 = *(const LAS bf16x8*)(kb + d0 * 2048 + 512);
                p0 = ATT_MFMA(a0, qr[d0], p0); p1 = ATT_MFMA(a1, qr[d0], p1); }
            if (jb >= 0) { const int kb_ = 64 * jb + 4 * hi;
#pragma unroll
                for (int r = 0; r < 16; ++r) { const int kv = kb_ + (r & 3) + 8 * (r >> 2); if (kv > qrel) p0[r] = -INFINITY; if (kv + 32 > qrel) p1[r] = -INFINITY; } }
            float rm = fmaxf(p0[0], p1[0]);
#pragma unroll
            for (int r = 1; r < 16; ++r) rm = fmaxf(rm, fmaxf(p0[r], p1[r]));
            rm = fmaxf(rm, __shfl_xor(rm, 32));
            if (__any(rm > mref + 8.f)) {
                const float mnew = fmaxf(mref, rm), f = pg8::ex2(mref - mnew); mref = mnew; l *= f;
                if (hi == 0) wsf[r32] = f;
#pragma unroll
                for (int r = 0; r < 16; ++r) { const float fr_ = wsf[crow(r, hi)];
#pragma unroll
                    for (int d = 0; d < 4; ++d) o[d][r] *= fr_; }
            }
            float sacc = 0.f;
#pragma unroll
            for (int r = 0; r < 16; ++r) { p0[r] = pg8::ex2(p0[r] - mref); p1[r] = pg8::ex2(p1[r] - mref); sacc += p0[r] + p1[r]; }
            l += sacc;
            v4u pw[4];
#pragma unroll
            for (int k = 0; k < 2; ++k) {
                pw[k] = (v4u){pg8::cvt_pk_bf16(p0[8 * k], p0[8 * k + 1]), pg8::cvt_pk_bf16(p0[8 * k + 2], p0[8 * k + 3]), pg8::cvt_pk_bf16(p0[8 * k + 4], p0[8 * k + 5]), pg8::cvt_pk_bf16(p0[8 * k + 6], p0[8 * k + 7])};
                pw[2 + k] = (v4u){pg8::cvt_pk_bf16(p1[8 * k], p1[8 * k + 1]), pg8::cvt_pk_bf16(p1[8 * k + 2], p1[8 * k + 3]), pg8::cvt_pk_bf16(p1[8 * k + 4], p1[8 * k + 5]), pg8::cvt_pk_bf16(p1[8 * k + 6], p1[8 * k + 7])}; }
            const LAS unsigned char* vb = lds + buf * 32768 + 16384 + (4 * hi + ((lane & 15) >> 2)) * 64 + ((lane >> 4) & 1) * 32 + (lane & 3) * 8;
#pragma unroll
            for (int d = 0; d < 4; ++d)
#pragma unroll
                for (int k = 0; k < 4; ++k) { const s16x4 lo = vtr(vb + (d * 4 + k) * 1024), hh = vtr(vb + (d * 4 + k) * 1024 + 512);
                    const bf16x8 vf = {lo[0], lo[1], lo[2], lo[3], hh[0], hh[1], hh[2], hh[3]};
                    o[d] = ATT_MFMA(__builtin_bit_cast(bf16x8, pw[k]), vf, o[d]); }
        }
        if (more) { LAS unsigned char* d = lds + (buf ^ 1) * 32768 + tid * 16; *(LAS v4u*)(d) = ks0; *(LAS v4u*)(d + 8192) = ks1; *(LAS v4u*)(d + 16384) = vs0; *(LAS v4u*)(d + 24576) = vs1; }
        __syncthreads();
    }
    l += __shfl_xor(l, 32);
    { float inv = 1.f / l; if (comp == 1) inv *= lam; if (hi == 0) wsf[r32] = inv; }
#pragma unroll
    for (int r = 0; r < 16; ++r) { const float ri = wsf[crow(r, hi)];
#pragma unroll
        for (int d = 0; d < 4; ++d) o[d][r] *= ri; }
    LAS f32x4* X = (LAS f32x4*)lds;
    if (comp == 1) {
#pragma unroll
        for (int d = 0; d < 4; ++d)
#pragma unroll
            for (int rq = 0; rq < 4; ++rq) X[((w4 * 4 + d) * 4 + rq) * 64 + lane] = (f32x4){o[d][4 * rq], o[d][4 * rq + 1], o[d][4 * rq + 2], o[d][4 * rq + 3]};
    }
    __syncthreads();
    if (comp == 0) {
        float ss[16];
#pragma unroll
        for (int r = 0; r < 16; ++r) ss[r] = 0.f;
#pragma unroll
        for (int d = 0; d < 4; ++d)
#pragma unroll
            for (int rq = 0; rq < 4; ++rq) { const f32x4 x = X[((w4 * 4 + d) * 4 + rq) * 64 + lane];
#pragma unroll
                for (int e = 0; e < 4; ++e) { const float y = o[d][4 * rq + e] - x[e]; o[d][4 * rq + e] = y; ss[4 * rq + e] += y * y; } }
#pragma unroll
        for (int r = 0; r < 16; ++r) {
#pragma unroll
            for (int off = 1; off < 32; off <<= 1) ss[r] += __shfl_xor(ss[r], off);
            ss[r] = 1.f / sqrtf(ss[r] * (1.f / 128.f) + RMS_EPS); }
        float gs[4];
#pragma unroll
        for (int d = 0; d < 4; ++d) gs[d] = gsub[32 * d + r32] * 0.8f;
        bf16* Op = CA + (rowbase + q0 + w4 * 32) * 2048 + 1024 + h * 128 + r32;
#pragma unroll
        for (int r = 0; r < 16; ++r) { bf16* rp = Op + (size_t)crow(r, hi) * 2048;
#pragma unroll
            for (int d = 0; d < 4; ++d) rp[32 * d] = (bf16)f2bf(o[d][r] * ss[r] * gs[d]); }
    }
    __syncthreads();
}
#undef ATT_MFMA
}

__device__ __forceinline__ void final_rows(Frame& F, float* out, const float* part, const float* gfin) {
    const int gw = F.vcu * NWAVES + F.wave, NGW = F.G * NWAVES;
    f32x4 g[4];
#pragma unroll
    for (int j = 0; j < 4; ++j) g[j] = *((const GAS f32x4*)gfin + F.lane + 64 * j);
    for (int m = gw; m < M; m += NGW) {
        GAS f32x4* xr = (GAS f32x4*)(out + (size_t)m * D) + F.lane;
        f32x4 v[4];
#pragma unroll
        for (int j = 0; j < 4; ++j) v[j] = xr[64 * j];
        const f32x4 p0 = *(const f32x4*)(part + (size_t)m * 16), p1 = *(const f32x4*)(part + (size_t)m * 16 + 4), p2 = *(const f32x4*)(part + (size_t)m * 16 + 8), p3 = *(const f32x4*)(part + (size_t)m * 16 + 12);
        const float s = (((p0[0] + p0[1]) + (p0[2] + p0[3])) + ((p1[0] + p1[1]) + (p1[2] + p1[3]))) + (((p2[0] + p2[1]) + (p2[2] + p2[3])) + ((p3[0] + p3[1]) + (p3[2] + p3[3])));
        const float rs = 1.f / sqrtf(s * (1.f / D) + RMS_EPS);
#pragma unroll
        for (int j = 0; j < 4; ++j) xr[64 * j] = v[j] * rs * g[j];
    }
}

struct Args { const float* in[21]; float* out; unsigned char* ws; int ph_lo, ph_hi, li, pad; };
__global__ void __launch_bounds__(NWAVES * 64, 2) hyb_fwd(Args args) {
    extern __shared__ __attribute__((aligned(16))) unsigned char lds[];
    Frame F;
    F.lds = (LAS unsigned char*)lds;
    F.MISC = (volatile LAS unsigned*)(F.lds + MISC_OFF);
    F.tid = threadIdx.x; F.lane = F.tid & 63; F.wave = __builtin_amdgcn_readfirstlane(F.tid >> 6);
    F.G = gridDim.x; { const int bx = blockIdx.x; F.vcu = (F.G % 8 == 0) ? (bx % 8) * (F.G / 8) + bx / 8 : bx; }
    unsigned char* ws = args.ws;
    F.ctl = (gu32*)(ws + WS_CTL);
#define IN_(k) (args.in[k])
#define x_ IN_(0)
#define g_mix IN_(1)
#define w_in IN_(2)
#define b_gate IN_(3)
#define w_dw IN_(4)
#define b_dw IN_(5)
#define g_cln IN_(6)
#define b_cln IN_(7)
#define w_cpw IN_(8)
#define lq1 IN_(9)
#define lk1 IN_(10)
#define lq2 IN_(11)
#define lk2 IN_(12)
#define g_sub IN_(13)
#define w_apw IN_(14)
#define w_out IN_(15)
#define g_ffn IN_(16)
#define w_fg IN_(17)
#define w_fu IN_(18)
#define w_fd IN_(19)
#define g_fin IN_(20)
#define out (args.out)
#define WIN ((bf16*)(ws + WS_WIN))
#define WCA ((bf16*)(ws + WS_WCA))
#define WO ((bf16*)(ws + WS_WO))
#define WGU ((bf16*)(ws + WS_WGU))
#define WD ((bf16*)(ws + WS_WD))
#define ROPE ((float*)(ws + WS_ROPE))
#define RS1 ((float*)(ws + WS_RS1))
#define PART1 ((float*)(ws + WS_PART1))
#define PART2 ((float*)(ws + WS_PART2))
#define XB ((bf16*)(ws + WS_XB))
#define U ((bf16*)(ws + WS_U))
#define CA ((bf16*)(ws + WS_CA))
#define VP ((bf16*)(ws + WS_V))
#define KP ((bf16*)(ws + WS_K))
#define MERGED ((bf16*)(ws + WS_MERGED))
#define X1B ((bf16*)(ws + WS_X1B))
#define FF ((bf16*)(ws + WS_FF))
#define GATES ((bf16*)out)

    for (int u = F.tid; u < (LDS_BYTES - LDSCTL_OFF) / 4; u += NWAVES * 64) ((LAS unsigned*)(F.lds + LDSCTL_OFF))[u] = 0u;
    __syncthreads();
    XcdBarrier bar; bar.bar = (unsigned*)(F.ctl + CW_BAR); bar.x = 0; bar.st = nullptr;
    if (N_LAUNCHES != PER_PHASE) bar = xcd_barrier_post((unsigned*)(F.ctl + CW_BAR), F.MISC + 8);
#define GRID_BAR() do { if (N_LAUNCHES != PER_PHASE) xcd_barrier(bar); } while (0)
    const int lo = args.ph_lo, hi = args.ph_hi;
#ifndef PH_MASK
#define PH_MASK 0xff
#endif
#define IN(k) (((PH_MASK >> (k)) & 1) && lo <= (k) && (k) < hi)
#define BOTH(k) (IN(k) && IN((k) + 1))
#ifdef PROBE_PHASE
#define STAMP(k) do { if (F.tid == 0) F.MISC[12 + (k)] = (unsigned)rt(); } while (0)
#else
#define STAMP(k) do { } while (0)
#endif
    STAMP(0);

    if (IN(0)) {
        P0Args a{x_, g_mix, w_in, w_cpw, w_apw, w_out, g_ffn, w_fg, w_fu, w_fd, WIN, WCA, WO, WGU, WD, XB, RS1, ROPE};
        p0_prologue(F, a);
        if (BOTH(0)) GRID_BAR();
        STAMP(1);
    }
    if (IN(1)) {
        pg8::Gemm g{XB, WIN, M, INC, D}; pg8::StaticOrder S; S.init(M, INC, F.G, (int)blockIdx.x);
        pg8::EpiIn E{U, CA, KP, VP, GATES, RS1, b_gate, ROPE};
        pg8::gemm_phase<pg8::EpiIn, pg8::StaticOrder, true, true>(F.lds + RING_OFF, g, S, E);
        if (BOTH(1)) GRID_BAR();
        STAMP(2);
    }
    if (IN(2)) {
#ifndef NO_CONV
        { ConvArgs ca{U, CA, w_dw, b_dw, g_cln, b_cln};
          for (int it = F.vcu * 4; it < M / 32; it += F.G * 4) for (int k = 0; k < 4; ++k) conv_item(F, ca, it + k); }
#endif
        STAMP(10);
#ifndef NO_ATTN
        const float d1 = wave_sum(lq1[F.lane] * lk1[F.lane]), d2 = wave_sum(lq2[F.lane] * lk2[F.lane]);
        const float lam = expf(d1) - expf(d2) + 0.2f;
        for (int v = F.vcu; v < 256; v += F.G) {
            const int bh = v >> 1, sub = v & 1;
            for (int i = 0; i < 8; ++i) { const int k = i >> 1; const int qb = (i & 1) ? (2 * k + sub) : (15 - 2 * k - sub);
                att::attn_unit(bh >> 3, bh & 7, qb, CA, KP, VP, g_sub, lam, F.lds + RING_OFF); }
        }
#endif
        if (BOTH(2)) GRID_BAR();
        STAMP(3);
    }
    if (IN(3)) {
        pg8::Gemm g{CA, WCA, M, D, 2 * D}; pg8::StaticOrder S; S.init(M, D, F.G, (int)blockIdx.x);
        pg8::EpiMerge E{GATES, MERGED};
        pg8::gemm_phase<pg8::EpiMerge, pg8::StaticOrder, true, true>(F.lds + RING_OFF, g, S, E);
        if (BOTH(3)) GRID_BAR();
        STAMP(4);
    }
    if (IN(4)) {
        pg8::Gemm g{MERGED, WO, M, D, D}; pg8::StaticOrder S; S.init(M, D, F.G, (int)blockIdx.x);
        pg8::EpiResidB E{XB, X1B, PART1};
        pg8::gemm_phase<pg8::EpiResidB, pg8::StaticOrder, true, true>(F.lds + RING_OFF, g, S, E);
        if (BOTH(4)) GRID_BAR();
        STAMP(5);
    }
    if (IN(5)) {
        pg8::Gemm g{X1B, WGU, M, 2 * DFF, D}; pg8::StaticOrder S; S.init(M, 2 * DFF, F.G, (int)blockIdx.x);
        pg8::EpiUp E{PART1, FF, DFF};
        pg8::gemm_phase<pg8::EpiUp, pg8::StaticOrder, true, true>(F.lds + RING_OFF, g, S, E);
        if (BOTH(5)) GRID_BAR();
        STAMP(6);
    }
    if (IN(6)) {
        pg8::Gemm g{FF, WD, M, D, DFF}; pg8::StaticOrder S; S.init(M, D, F.G, (int)blockIdx.x);
        pg8::EpiResidF E{X1B, out, PART2};
        pg8::gemm_phase<pg8::EpiResidF, pg8::StaticOrder, true, true>(F.lds + RING_OFF, g, S, E);
        if (BOTH(6)) GRID_BAR();
        STAMP(7);
    }
    if (IN(7)) final_rows(F, out, PART2, g_fin);
#ifdef PROBE_PHASE
    STAMP(8);
    if (blockIdx.x == 0 && F.tid == 0) { asm volatile("s_waitcnt vmcnt(0) lgkmcnt(0)" ::: "memory"); { const float t01 = (PROBE_PHASE == 20) ? (float)(F.MISC[22] - F.MISC[14]) * 0.1f : (float)(F.MISC[12 + (PROBE_PHASE % 8) + 1] - F.MISC[12 + (PROBE_PHASE % 8)]) * 0.1f; out[0] = floorf(t01 * (1.0f / PROBE_UNIT)) + 0.5f; } }
#endif
#undef IN
#undef BOTH
#undef GRID_BAR
#undef STAMP
#undef IN_
#undef x_
#undef g_mix
#undef w_in
#undef b_gate
#undef w_dw
#undef b_dw
#undef g_cln
#undef b_cln
#undef w_cpw
#undef lq1
#undef lk1
#undef lq2
#undef lk2
#undef g_sub
#undef w_apw
#undef w_out
#undef g_ffn
#undef w_fg
#undef w_fu
#undef w_fd
#undef g_fin
#undef out
#undef WIN
#undef WCA
#undef WO
#undef WGU
#undef WD
#undef ROPE
#undef RS1
#undef PART1
#undef PART2
#undef XB
#undef U
#undef CA
#undef VP
#undef KP
#undef MERGED
#undef X1B
#undef FF
#undef GATES
}

extern "C" void kernel_launch(void* const* d_in, const int* in_sizes, int n_in, void* d_out, int out_size, void* d_ws, size_t ws_size, hipStream_t stream) {
    static int grid = 0;
    if (grid == 0) {
        if (n_in != 21 || in_sizes[0] != M * D || out_size != M * D || ws_size < WS_END) { fprintf(stderr, "kernel_launch: unexpected problem: n_in %d in0 %d out %d ws %zu; nothing launched\n", n_in, n_in > 0 ? in_sizes[0] : -1, out_size, ws_size); grid = -1; return; }
        int dev = 0, cus = 0, per_cu = 0;
        if (hipGetDevice(&dev) != hipSuccess || hipDeviceGetAttribute(&cus, hipDeviceAttributeMultiprocessorCount, dev) != hipSuccess) { fprintf(stderr, "kernel_launch: device query failed\n"); grid = -1; return; }
        if (hipFuncSetAttribute((const void*)hyb_fwd, hipFuncAttributeMaxDynamicSharedMemorySize, LDS_BYTES) != hipSuccess) { fprintf(stderr, "kernel_launch: hipFuncSetAttribute failed\n"); grid = -1; return; }
        if (hipOccupancyMaxActiveBlocksPerMultiprocessor(&per_cu, (const void*)hyb_fwd, NWAVES * 64, LDS_BYTES) != hipSuccess || per_cu < 1)
            fprintf(stderr, "kernel_launch: note: occupancy query reports %d workgroups per CU\n", per_cu);
        (void)hipGetLastError();
        grid = cus;
        if (grid > 256) grid = 256;
    }
    if (grid < 0) return;
    if (hipMemsetAsync((char*)d_ws + WS_CTL, 0, CTL_ZERO_BYTES, stream) != hipSuccess) { fprintf(stderr, "kernel_launch: hipMemsetAsync failed\n"); return; }
    Args a{};
    for (int i = 0; i < 21; ++i) a.in[i] = (const float*)d_in[i];
    a.out = (float*)d_out; a.ws = (unsigned char*)d_ws;
    if (N_LAUNCHES == 1) { a.ph_lo = 0; a.ph_hi = PER_PHASE; a.li = 0; hipLaunchKernelGGL(hyb_fwd, dim3(grid), dim3(NWAVES * 64), LDS_BYTES, stream, a); }
    else for (int li = 0; li < PER_PHASE; ++li) { a.ph_lo = li; a.ph_hi = li + 1; a.li = li; hipLaunchKernelGGL(hyb_fwd, dim3(grid), dim3(NWAVES * 64), LDS_BYTES, stream, a); }
    const hipError_t le = hipPeekAtLastError();
    if (le != hipSuccess) fprintf(stderr, "kernel_launch: launch failed: %s\n", hipGetErrorName(le));
}
```

```cpp
#include <hip/hip_runtime.h>
#include <cstdio>
#include <cstdint>
namespace pg8 {
#define PG8_LAS __attribute__((address_space(3)))
typedef unsigned short bf16_t;
typedef short bf16x8 __attribute__((ext_vector_type(8)));
typedef float f32x4 __attribute__((ext_vector_type(4)));
typedef unsigned u32x4 __attribute__((ext_vector_type(4)));
constexpr int BM = 256, BK = 64, HALF = 128, HTB = HALF * BK * 2  , STAGE_BYTES = 8 * HTB, NXCD = 8, WGM = 8;

__host__ __device__ __forceinline__ int lds_byte(int r, int c) { const int st = (r >> 4) * 2 + (c >> 5), rr = r & 15, cc = c & 31, ob = rr * 64 + cc * 2; return st * 1024 + (ob ^ (((ob >> 9) & 1) << 5)); }
__host__ __device__ __forceinline__ void stage_rc(int b, int& R, int& C) { const int st = b / 1024, sb = b % 1024, swz = sb ^ (((sb >> 9) & 1) << 5); R = (st >> 1) * 16 + swz / 64; C = (st & 1) * 32 + (swz % 64) / 2; }
__host__ __device__ __forceinline__ int perm32(int rho) { const int n = rho >> 4, i = rho & 15; return 8 * (i >> 2) + 4 * n + (i & 3); }

struct Unit { int pm, pn; };
struct Gemm { const bf16_t* A; const bf16_t* Bt; int M, N, K; };

struct StaticOrder {
    int nM, nN, nwg, G, c;
    __host__ __device__ void init(int M, int N, int G_, int c_) { nM = M / BM; nN = N / BM; nwg = nM * nN; G = G_; c = c_; }
    __host__ __device__ bool next(int i, Unit& u) const {
        const long L = (long)i * G + c; if (L >= nwg) return false;
        int wgid = (int)L; { const int q = nwg / NXCD, r = nwg % NXCD, xcd = wgid % NXCD, off = wgid / NXCD; wgid = (xcd < r ? xcd * (q + 1) : r * (q + 1) + (xcd - r) * q) + off; }
        const int nig = WGM * nN, gid = wgid / nig, fm = gid * WGM, gsz = (nM - fm) < WGM ? (nM - fm) : WGM;
        u.pm = fm + ((wgid % nig) % gsz); u.pn = (wgid % nig) / gsz; return true;
    }
    __device__ __forceinline__ void a_ready(const Unit&) const {}
    __device__ __forceinline__ void done(const Unit&) const {}
};

__device__ __forceinline__ unsigned cvt_pk_bf16(float lo, float hi) { unsigned r; asm volatile("v_cvt_pk_bf16_f32 %0, %1, %2" : "=v"(r) : "v"(lo), "v"(hi)); return r; }
__device__ __forceinline__ float bf_lo(unsigned w) { return __uint_as_float(w << 16); }
__device__ __forceinline__ float bf_hi(unsigned w) { return __uint_as_float(w & 0xffff0000u); }
constexpr float LOG2E = 1.4426950408889634f;
__device__ __forceinline__ float ex2(float x) { return __builtin_amdgcn_exp2f(x); }
__device__ __forceinline__ float rcpf_(float x) { return __builtin_amdgcn_rcpf(x); }
__device__ __forceinline__ float sigm(float x) { return rcpf_(1.f + ex2(-x * LOG2E)); }
__device__ __forceinline__ u32x4 pack8(const f32x4 a, const f32x4 b) { u32x4 w; w.x = cvt_pk_bf16(a[0], a[1]); w.y = cvt_pk_bf16(a[2], a[3]); w.z = cvt_pk_bf16(b[0], b[1]); w.w = cvt_pk_bf16(b[2], b[3]); return w; }

constexpr int SEQ_ = 2048;
constexpr float QSCALE = 0.125f * 1.4426950408889634f;

struct EpiIn {
    static constexpr bool PERM = true, AFTER_DRAIN = false, MID = false;
    bf16_t* U; bf16_t* CA; bf16_t* Kp; bf16_t* Vp; bf16_t* G; const float* rs1; const float* bgate; const float* rope;
    __device__ __forceinline__ void operator()(const f32x4 (&acc)[2][2][4][2], const Unit& u, int wr, int wc, int fr, int fq) const {
        const int pn = u.pn, rowb = u.pm * BM + wr * 64 + fr;
        if (pn < 8) {
            bf16_t* base = U + pn * 128 + wc * 32 + fq * 8;
#pragma unroll
            for (int ai = 0; ai < 2; ++ai)
#pragma unroll
                for (int m = 0; m < 4; ++m) { const int r = rowb + ai * HALF + m * 16; const float rs = rs1[r]; f32x4 o[2];
#pragma unroll
                    for (int n = 0; n < 2; ++n) { const f32x4 a = acc[ai][0][m][n] * rs, g = acc[ai][1][m][n] * rs;
#pragma unroll
                        for (int e = 0; e < 4; ++e) o[n][e] = a[e] * sigm(g[e]); }
                    *(u32x4*)(base + (size_t)r * 1024) = pack8(o[0], o[1]); }
        } else if (pn < 16) {
            const bool isq = pn < 12; const bool dorope = ((wc & 1) == 0) && (fq < 2);
#pragma unroll
            for (int ai = 0; ai < 2; ++ai)
#pragma unroll
                for (int m = 0; m < 4; ++m) { const int r = rowb + ai * HALF + m * 16; const float rs = rs1[r]; const int pos = r & (SEQ_ - 1);
                    f32x4 cs0 = {1.f, 0.f, 1.f, 0.f}, cs1 = {1.f, 0.f, 1.f, 0.f};
                    if (dorope) { const float* rp = rope + ((size_t)pos * 8 + 4 * fq) * 2; cs0 = *(const f32x4*)rp; cs1 = *(const f32x4*)(rp + 4); }
#pragma unroll
                    for (int bj = 0; bj < 2; ++bj) { f32x4 v0 = acc[ai][bj][m][0] * rs, v1 = acc[ai][bj][m][1] * rs;
                        { const float a = v0[0], b = v0[1], c = v0[2], d = v0[3];
                          v0[0] = a * cs0[0] - b * cs0[1]; v0[1] = b * cs0[0] + a * cs0[1]; v0[2] = c * cs0[2] - d * cs0[3]; v0[3] = d * cs0[2] + c * cs0[3]; }
                        { const float a = v1[0], b = v1[1], c = v1[2], d = v1[3];
                          v1[0] = a * cs1[0] - b * cs1[1]; v1[1] = b * cs1[0] + a * cs1[1]; v1[2] = c * cs1[2] - d * cs1[3]; v1[3] = d * cs1[2] + c * cs1[3]; }
                        if (isq) { v0 = v0 * QSCALE; v1 = v1 * QSCALE;
                            *(u32x4*)(CA + (size_t)r * 2048 + 1024 + (pn - 8) * 256 + bj * HALF + wc * 32 + fq * 8) = pack8(v0, v1);
                        } else { const int b_ = r >> 11, tile = pos >> 6, row = pos & 63, h = 2 * (pn - 12) + bj, comp = wc >> 1, chunk = 4 * (wc & 1) + fq;
                            *(u32x4*)(Kp + ((size_t)((((b_ * 8 + h) * 32 + tile) * 2 + comp) * 8 + chunk) * 64 + row) * 8) = pack8(v0, v1); } } }
        } else if (pn < 20) {
#pragma unroll
            for (int ai = 0; ai < 2; ++ai)
#pragma unroll
                for (int m = 0; m < 4; ++m) { const int r = rowb + ai * HALF + m * 16; const float rs = rs1[r]; const int pos = r & (SEQ_ - 1), b_ = r >> 11, tile = pos >> 6, ks = (pos & 63) >> 4, r16 = pos & 15;
#pragma unroll
                    for (int bj = 0; bj < 2; ++bj) { const int h = 2 * (pn - 16) + bj; const f32x4 v0 = acc[ai][bj][m][0] * rs, v1 = acc[ai][bj][m][1] * rs;
                        *(u32x4*)(Vp + ((size_t)(((b_ * 8 + h) * 32 + tile) * 16 + wc * 4 + ks) * 16 + r16) * 32 + fq * 8) = pack8(v0, v1); } }
        } else {
            const int ch = (pn - 20) * 128 + wc * 32 + fq * 8;
            const f32x4 bc0 = *(const f32x4*)(bgate + ch), bc1 = *(const f32x4*)(bgate + ch + 4), ba0 = *(const f32x4*)(bgate + 1024 + ch), ba1 = *(const f32x4*)(bgate + 1024 + ch + 4);
#pragma unroll
            for (int ai = 0; ai < 2; ++ai)
#pragma unroll
                for (int m = 0; m < 4; ++m) { const int r = rowb + ai * HALF + m * 16; const float rs = rs1[r]; f32x4 rt[2], ga[2];
#pragma unroll
                    for (int n = 0; n < 2; ++n) { const f32x4 xc = acc[ai][0][m][n] * rs + (n ? bc1 : bc0), xa = acc[ai][1][m][n] * rs + (n ? ba1 : ba0);
#pragma unroll
                        for (int e = 0; e < 4; ++e) { const float ea = ex2(fminf(-xa[e] * LOG2E, 80.f)), ec = ex2(-xc[e] * LOG2E); ga[n][e] = rcpf_(1.f + ea); rt[n][e] = (1.f + ea) * rcpf_(1.f + ec); } }
                    *(u32x4*)(G + (size_t)r * 2048 + ch) = pack8(rt[0], rt[1]);
                    *(u32x4*)(G + (size_t)r * 2048 + 1024 + ch) = pack8(ga[0], ga[1]); }
        }
    }
};

struct EpiMerge {
    static constexpr bool PERM = true, AFTER_DRAIN = false, MID = true;
    const bf16_t* G; bf16_t* O;
    __device__ __forceinline__ void mid(f32x4 (&acc)[2][2][4][2], const Unit& u, int wr, int wc, int fr, int fq) const {
        asm volatile("" : "+v"(fr), "+v"(fq));
        const int rowb = u.pm * BM + wr * 64 + fr, col = u.pn * BM + wc * 32 + fq * 8;
#pragma unroll
        for (int ai = 0; ai < 2; ++ai)
#pragma unroll
            for (int m = 0; m < 4; ++m) { const bf16_t* gp = G + (size_t)(rowb + ai * HALF + m * 16) * 2048 + col;
#pragma unroll
                for (int bj = 0; bj < 2; ++bj) { const u32x4 w = *(const u32x4*)(gp + bj * HALF);
                    acc[ai][bj][m][0] *= (f32x4){bf_lo(w.x), bf_hi(w.x), bf_lo(w.y), bf_hi(w.y)}; acc[ai][bj][m][1] *= (f32x4){bf_lo(w.z), bf_hi(w.z), bf_lo(w.w), bf_hi(w.w)}; }
                if (m & 1) asm volatile("" ::: "memory"); }
    }
    __device__ __forceinline__ void operator()(const f32x4 (&acc)[2][2][4][2], const Unit& u, int wr, int wc, int fr, int fq) const {
        const int rowb = u.pm * BM + wr * 64 + fr, col = u.pn * BM + wc * 32 + fq * 8;
#pragma unroll
        for (int ai = 0; ai < 2; ++ai)
#pragma unroll
            for (int m = 0; m < 4; ++m) { const int r = rowb + ai * HALF + m * 16; const bf16_t* gp = G + (size_t)r * 2048 + 1024 + col;
#pragma unroll
                for (int bj = 0; bj < 2; ++bj) { const u32x4 w = *(const u32x4*)(gp + bj * HALF);
                    const f32x4 v0 = acc[ai][bj][m][0] * (f32x4){bf_lo(w.x), bf_hi(w.x), bf_lo(w.y), bf_hi(w.y)}, v1 = acc[ai][bj][m][1] * (f32x4){bf_lo(w.z), bf_hi(w.z), bf_lo(w.w), bf_hi(w.w)};
                    *(u32x4*)(O + (size_t)r * 1024 + col + bj * HALF) = pack8(v0, v1); } }
    }
};

struct EpiResidB {
    static constexpr bool PERM = true, AFTER_DRAIN = false, MID = false;
    const bf16_t* base; bf16_t* ob; float* part;
    __device__ __forceinline__ void operator()(const f32x4 (&acc)[2][2][4][2], const Unit& u, int wr, int wc, int fr, int fq) const {
        const int rowb = u.pm * BM + wr * 64 + fr, col0 = u.pn * BM + wc * 32 + 8 * fq;
#pragma unroll
        for (int ai = 0; ai < 2; ++ai)
#pragma unroll
            for (int m = 0; m < 4; ++m) { const int r = rowb + ai * HALF + m * 16; const size_t off = (size_t)r * 1024 + col0; float ss = 0.f;
#pragma unroll
                for (int bj = 0; bj < 2; ++bj) { const u32x4 w = *(const u32x4*)(base + off + bj * HALF);
                    const f32x4 v0 = acc[ai][bj][m][0] + (f32x4){bf_lo(w.x), bf_hi(w.x), bf_lo(w.y), bf_hi(w.y)}, v1 = acc[ai][bj][m][1] + (f32x4){bf_lo(w.z), bf_hi(w.z), bf_lo(w.w), bf_hi(w.w)};
                    ss += ((v0[0] * v0[0] + v0[1] * v0[1]) + (v0[2] * v0[2] + v0[3] * v0[3])) + ((v1[0] * v1[0] + v1[1] * v1[1]) + (v1[2] * v1[2] + v1[3] * v1[3]));
                    *(u32x4*)(ob + off + bj * HALF) = pack8(v0, v1); }
                ss += __shfl_xor(ss, 16); ss += __shfl_xor(ss, 32);
                if (fq == 0) part[(size_t)r * 16 + u.pn * 4 + wc] = ss; }
    }
};
struct EpiResidF {
    static constexpr bool PERM = true, AFTER_DRAIN = false, MID = false;
    const bf16_t* base; float* out; float* part;
    __device__ __forceinline__ void operator()(const f32x4 (&acc)[2][2][4][2], const Unit& u, int wr, int wc, int fr, int fq) const {
        const int rowb = u.pm * BM + wr * 64 + fr, col0 = u.pn * BM + wc * 32 + 8 * fq;
#pragma unroll
        for (int ai = 0; ai < 2; ++ai)
#pragma unroll
            for (int m = 0; m < 4; ++m) { const int r = rowb + ai * HALF + m * 16; const size_t off = (size_t)r * 1024 + col0; float ss = 0.f;
#pragma unroll
                for (int bj = 0; bj < 2; ++bj) { const u32x4 w = *(const u32x4*)(base + off + bj * HALF);
                    const f32x4 v0 = acc[ai][bj][m][0] + (f32x4){bf_lo(w.x), bf_hi(w.x), bf_lo(w.y), bf_hi(w.y)}, v1 = acc[ai][bj][m][1] + (f32x4){bf_lo(w.z), bf_hi(w.z), bf_lo(w.w), bf_hi(w.w)};
                    ss += ((v0[0] * v0[0] + v0[1] * v0[1]) + (v0[2] * v0[2] + v0[3] * v0[3])) + ((v1[0] * v1[0] + v1[1] * v1[1]) + (v1[2] * v1[2] + v1[3] * v1[3]));
                    *(f32x4*)(out + off + bj * HALF) = v0; *(f32x4*)(out + off + bj * HALF + 4) = v1; }
                ss += __shfl_xor(ss, 16); ss += __shfl_xor(ss, 32);
                if (fq == 0) part[(size_t)r * 16 + u.pn * 4 + wc] = ss; }
    }
};

struct EpiUp {
    static constexpr bool PERM = true, AFTER_DRAIN = false, MID = false;
    const float* part; bf16_t* FF; int ldf;
    __device__ __forceinline__ void operator()(const f32x4 (&acc)[2][2][4][2], const Unit& u, int wr, int wc, int fr, int fq) const {
        const int rowb = u.pm * BM + wr * 64 + fr; bf16_t* base = FF + u.pn * 128 + wc * 32 + fq * 8;
#pragma unroll
        for (int ai = 0; ai < 2; ++ai)
#pragma unroll
            for (int m = 0; m < 4; ++m) { const int r = rowb + ai * HALF + m * 16; const f32x4 pv = *(const f32x4*)(part + (size_t)r * 16 + 4 * fq);
                float s = (pv[0] + pv[1]) + (pv[2] + pv[3]); s += __shfl_xor(s, 16); s += __shfl_xor(s, 32);
                const float rs = 1.0f / sqrtf(s * (1.0f / 1024.0f) + 1e-6f); f32x4 o[2];
#pragma unroll
                for (int n = 0; n < 2; ++n) { const f32x4 g = acc[ai][0][m][n] * rs, up = acc[ai][1][m][n] * rs;
#pragma unroll
                    for (int e = 0; e < 4; ++e) o[n][e] = g[e] * sigm(g[e]) * up[e]; }
                *(u32x4*)(base + (size_t)r * ldf) = pack8(o[0], o[1]); }
    }
};

template <class Epi, class Sched, bool ALIGN_EPI = false, bool SP2 = false>
__device__ __forceinline__ void gemm_phase(PG8_LAS unsigned char* lds, const Gemm g, const Sched& S, const Epi& E) {
    const int tid = threadIdx.x, wid = __builtin_amdgcn_readfirstlane(tid >> 6), lane = tid & 63, wr = wid >> 2, wc = wid & 3, fr = lane & 15, fq = lane >> 4;
    const int K = g.K, nt = K / BK;
    unsigned voffA[2], voffB[2];
#pragma unroll
    for (int i = 0; i < 2; ++i) { int R, C; stage_rc(tid * 16 + i * 8192, R, C); const int Rb = Epi::PERM ? ((R & ~31) + perm32(R & 31)) : R;
        voffA[i] = (unsigned)(R * K + C) * 2u; voffB[i] = (unsigned)(Rb * K + C) * 2u; }
    const size_t kstep = (size_t)(BK * 2);
    const size_t hstep = (size_t)HALF * K * 2;
    const size_t tstep = 2 * hstep;
    const unsigned ldsw = (unsigned)wid * 1024u;
    const int aoff = lds_byte(wr * 64 + fr, fq * 8), boff = lds_byte(wc * 32 + fr, fq * 8);
#define PG8_SA(b, h) (((b) * 2 + (h)) * HTB)
#define PG8_SB(b, h) ((4 + (b) * 2 + (h)) * HTB)
#define PG8_STAGE(bufoff, gbase, voff) do { _Pragma("unroll") for (int _i = 0; _i < 2; ++_i) \
        __builtin_amdgcn_global_load_lds((const unsigned*)((const char*)(gbase) + (voff)[_i]), (PG8_LAS unsigned*)(lds + (bufoff) + ldsw + _i * 8192), 16, 0, 0); } while (0)
#define PG8_LDA(dst, b, h) do { _Pragma("unroll") for (int m = 0; m < 4; ++m) _Pragma("unroll") for (int k = 0; k < 2; ++k) dst[m][k] = *(const PG8_LAS bf16x8*)(lds + PG8_SA(b, h) + aoff + m * 2048 + k * 1024); } while (0)
#define PG8_LDB(dst, b, h) do { _Pragma("unroll") for (int n = 0; n < 2; ++n) _Pragma("unroll") for (int k = 0; k < 2; ++k) dst[n][k] = *(const PG8_LAS bf16x8*)(lds + PG8_SB(b, h) + boff + n * 2048 + k * 1024); } while (0)
#define PG8_MMA(ai, bj, At, Bt) do { __builtin_amdgcn_s_setprio(1); _Pragma("unroll") for (int m = 0; m < 4; ++m) _Pragma("unroll") for (int n = 0; n < 2; ++n) _Pragma("unroll") for (int k = 0; k < 2; ++k) \
        acc[ai][bj][m][n] = __builtin_amdgcn_mfma_f32_16x16x32_bf16(Bt[n][k], At[m][k], acc[ai][bj][m][n], 0, 0, 0); __builtin_amdgcn_s_setprio(0); } while (0)
#define PG8_WAIT_V(n) asm volatile("s_waitcnt vmcnt(" #n ")" ::: "memory")
#define PG8_WAIT_L(n) asm volatile("s_waitcnt lgkmcnt(" #n ")" ::: "memory")
#define PG8_BAR __builtin_amdgcn_s_barrier()
#define PG8_SCHED __builtin_amdgcn_sched_barrier(0)
    Unit cur, nxt; int ui = 0;
    if (!S.next(0, cur)) return;
    f32x4 acc[2][2][4][2];
#pragma unroll
    for (int a = 0; a < 2; ++a)
#pragma unroll
        for (int b = 0; b < 2; ++b)
#pragma unroll
            for (int m = 0; m < 4; ++m)
#pragma unroll
                for (int n = 0; n < 2; ++n) acc[a][b][m][n] = (f32x4){0.f, 0.f, 0.f, 0.f};
    bf16x8 At[4][2], B0[2][2], B1[2][2];
    const char* cA = (const char*)g.A + (size_t)cur.pm * tstep; const char* cB = (const char*)g.Bt + (size_t)cur.pn * tstep;
    S.a_ready(cur);
    if constexpr (SP2) {
        PG8_STAGE(PG8_SB(0, 0), cB, voffB); PG8_STAGE(PG8_SB(0, 1), cB + hstep, voffB); PG8_STAGE(PG8_SA(0, 0), cA, voffA); PG8_STAGE(PG8_SA(0, 1), cA + hstep, voffA);
        if (wr == 1) PG8_BAR;
        PG8_WAIT_V(2); PG8_BAR;
        PG8_STAGE(PG8_SB(1, 0), cB + kstep, voffB); PG8_STAGE(PG8_SA(1, 0), cA + kstep, voffA); PG8_STAGE(PG8_SB(1, 1), cB + hstep + kstep, voffB);
        PG8_WAIT_V(6); PG8_BAR;
    } else {
        PG8_STAGE(PG8_SB(0, 0), cB, voffB); PG8_STAGE(PG8_SA(0, 0), cA, voffA); PG8_STAGE(PG8_SB(0, 1), cB + hstep, voffB); PG8_STAGE(PG8_SA(0, 1), cA + hstep, voffA);
        if (wr == 1) PG8_BAR;
        PG8_WAIT_V(4); PG8_BAR;
        PG8_STAGE(PG8_SB(1, 0), cB + kstep, voffB); PG8_STAGE(PG8_SA(1, 0), cA + kstep, voffA); PG8_STAGE(PG8_SB(1, 1), cB + hstep + kstep, voffB);
        PG8_WAIT_V(6); PG8_BAR;
    }
    for (;;) {
        const bool has_next = S.next(ui + 1, nxt);
        const char* nA = has_next ? (const char*)g.A + (size_t)nxt.pm * tstep : cA; const char* nB = has_next ? (const char*)g.Bt + (size_t)nxt.pn * tstep : cB;
        for (int t = 0; t < nt; t += 2) {
            if constexpr (Epi::MID) { if (t == (nt >> 1)) E.mid(acc, cur, wr, wc, fr, fq); }
            const bool last = (t == nt - 2);
            const char* a1 = cA + (size_t)(t + 1) * kstep;
            const char* a2 = last ? nA : cA + (size_t)(t + 2) * kstep; const char* b2 = last ? nB : cB + (size_t)(t + 2) * kstep;
            const char* a3 = a2 + kstep; const char* b3 = b2 + kstep;
            if (last && has_next) S.a_ready(nxt);
            if constexpr (SP2) {
            PG8_LDB(B0, 0, 0); PG8_LDB(B1, 0, 1); PG8_SCHED; PG8_LDA(At, 0, 0); PG8_STAGE(PG8_SA(1, 1), a1 + hstep, voffA);
            PG8_WAIT_V(8); PG8_WAIT_L(0); PG8_BAR; PG8_MMA(0, 0, At, B0); PG8_MMA(0, 1, At, B1); PG8_BAR; PG8_SCHED;
            PG8_LDA(At, 0, 1); PG8_STAGE(PG8_SB(0, 0), b2, voffB); PG8_STAGE(PG8_SB(0, 1), b2 + hstep, voffB); PG8_STAGE(PG8_SA(0, 0), a2, voffA);
            PG8_WAIT_V(8); PG8_WAIT_L(0); PG8_BAR; PG8_MMA(1, 0, At, B0); PG8_MMA(1, 1, At, B1); PG8_BAR; PG8_SCHED;
            PG8_LDB(B0, 1, 0); PG8_LDB(B1, 1, 1); PG8_SCHED; PG8_LDA(At, 1, 0); PG8_STAGE(PG8_SA(0, 1), a2 + hstep, voffA);
            PG8_WAIT_V(8); PG8_WAIT_L(0); PG8_BAR; PG8_MMA(0, 0, At, B0); PG8_MMA(0, 1, At, B1); PG8_BAR; PG8_SCHED;
            PG8_LDA(At, 1, 1); PG8_STAGE(PG8_SB(1, 0), b3, voffB); PG8_STAGE(PG8_SB(1, 1), b3 + hstep, voffB); PG8_STAGE(PG8_SA(1, 0), a3, voffA);
            PG8_WAIT_V(8); PG8_WAIT_L(0); PG8_BAR; PG8_MMA(1, 0, At, B0); PG8_MMA(1, 1, At, B1); PG8_BAR; PG8_SCHED;
            } else {
            PG8_LDB(B0, 0, 0); PG8_SCHED; PG8_LDA(At, 0, 0); PG8_STAGE(PG8_SA(1, 1), a1 + hstep, voffA);
            PG8_WAIT_L(8); PG8_BAR; PG8_WAIT_L(0); PG8_MMA(0, 0, At, B0); PG8_BAR; PG8_SCHED;
            PG8_LDB(B1, 0, 1); PG8_STAGE(PG8_SB(0, 0), b2, voffB);
            PG8_BAR; PG8_WAIT_L(0); PG8_MMA(0, 1, At, B1); PG8_BAR;
            PG8_LDA(At, 0, 1); PG8_STAGE(PG8_SA(0, 0), a2, voffA);
            PG8_BAR; PG8_WAIT_L(0); PG8_MMA(1, 0, At, B0); PG8_BAR; PG8_SCHED;
            PG8_STAGE(PG8_SB(0, 1), b2 + hstep, voffB);
            PG8_WAIT_V(6); PG8_BAR; PG8_MMA(1, 1, At, B1); PG8_BAR;
            PG8_LDB(B0, 1, 0); PG8_SCHED; PG8_LDA(At, 1, 0); PG8_STAGE(PG8_SA(0, 1), a2 + hstep, voffA);
            PG8_WAIT_L(8); PG8_BAR; PG8_WAIT_L(0); PG8_MMA(0, 0, At, B0); PG8_BAR; PG8_SCHED;
            PG8_LDB(B1, 1, 1); PG8_STAGE(PG8_SB(1, 0), b3, voffB);
            PG8_BAR; PG8_WAIT_L(0); PG8_MMA(0, 1, At, B1); PG8_BAR;
            PG8_LDA(At, 1, 1); PG8_STAGE(PG8_SA(1, 0), a3, voffA);
            PG8_BAR; PG8_WAIT_L(0); PG8_MMA(1, 0, At, B0); PG8_BAR; PG8_SCHED;
            PG8_STAGE(PG8_SB(1, 1), b3 + hstep, voffB);
            PG8_WAIT_V(6); PG8_BAR; PG8_MMA(1, 1, At, B1); PG8_BAR;
            }
        }
        if constexpr (ALIGN_EPI) { if (wr == 0) PG8_BAR; }
        if constexpr (!Epi::AFTER_DRAIN) { E(acc, cur, wr, wc, fr, fq); S.done(cur); }
        if (!has_next) break;
#pragma unroll
        for (int a = 0; a < 2; ++a)
#pragma unroll
            for (int b = 0; b < 2; ++b)
#pragma unroll
                for (int m = 0; m < 4; ++m)
#pragma unroll
                    for (int n = 0; n < 2; ++n) acc[a][b][m][n] = (f32x4){0.f, 0.f, 0.f, 0.f};
        cur = nxt; cA = nA; cB = nB; ++ui;
        if constexpr (ALIGN_EPI) { if (wr == 1) PG8_BAR; }
    }
    PG8_WAIT_V(0);
    if constexpr (!ALIGN_EPI) { if (wr == 0) PG8_BAR; }
    PG8_BAR;
    if constexpr (Epi::AFTER_DRAIN) { E.fused(acc, cur, wr, wc, fr, fq, lds, wid, lane); S.done(cur); }
#undef PG8_SA
#undef PG8_SB
#undef PG8_STAGE
#undef PG8_LDA
#undef PG8_LDB
#undef PG8_MMA
#undef PG8_WAIT_V
#undef PG8_WAIT_L
#undef PG8_BAR
#undef PG8_SCHED
}
}

constexpr int NWAVES = 8;
#ifndef MK_N_LAUNCHES
#define MK_N_LAUNCHES 1
#endif
constexpr int PER_PHASE = 8;
constexpr int N_LAUNCHES = MK_N_LAUNCHES;

constexpr int BATCH = 16, SEQ = 2048, D = 1024, M = BATCH * SEQ, NH = 8, DFF = 2816, INC = 7168;
constexpr float RMS_EPS = 1e-6f, LN_EPS = 1e-5f;

constexpr size_t MiB = 1u << 20;
constexpr size_t WS_CTL = 0, CTL_ZERO_BYTES = 1 * MiB;
constexpr size_t WS_WIN = 2 * MiB;
constexpr size_t WS_WCA = 16 * MiB;
constexpr size_t WS_WO = 20 * MiB;
constexpr size_t WS_WGU = 22 * MiB;
constexpr size_t WS_WD = 33 * MiB;
constexpr size_t WS_ROPE = 40 * MiB;
constexpr size_t WS_RS1 = 40 * MiB + 256 * 1024;
constexpr size_t WS_PART1 = 41 * MiB, WS_PART2 = 43 * MiB;
constexpr size_t WS_XB = 48 * MiB;
constexpr size_t WS_U = 112 * MiB;
constexpr size_t WS_CA = 176 * MiB;
constexpr size_t WS_V = 304 * MiB;
constexpr size_t WS_K = 368 * MiB;
constexpr size_t WS_MERGED = 432 * MiB;
constexpr size_t WS_END = 496 * MiB;
constexpr size_t WS_X1B = WS_U, WS_FF = WS_CA;
static_assert(WS_WD + (size_t)D * DFF * 2 <= WS_ROPE && WS_FF + (size_t)M * DFF * 2 <= WS_K && WS_PART2 + (size_t)M * 64 <= WS_XB, "d_ws map");
constexpr int CW_TMO = 0, CW_CODE = 1;
constexpr int CW_BAR = 4096;

constexpr int RING_OFF = 0, RING_BYTES = 131072;
constexpr int LDSCTL_OFF = RING_BYTES, MISC_OFF = LDSCTL_OFF + 320;
constexpr int LDS_BYTES = 147456;
static_assert(MISC_OFF + 128 <= LDS_BYTES, "LDS map");
#define GAS __attribute__((address_space(1)))
#define LAS __attribute__((address_space(3)))
typedef unsigned short bf16;
typedef unsigned v4u __attribute__((ext_vector_type(4)));
typedef float f32x4 __attribute__((ext_vector_type(4)));
typedef short bf16x8 __attribute__((ext_vector_type(8)));
typedef GAS unsigned gu32;
typedef GAS unsigned long long gu64;
#define RLX_AGENT __ATOMIC_RELAXED, __HIP_MEMORY_SCOPE_AGENT
#define LDS_WAIT() asm volatile("s_waitcnt lgkmcnt(0)" ::: "memory")
#define VM_WAIT() asm volatile("s_waitcnt vmcnt(0)" ::: "memory")
__device__ __forceinline__ unsigned long long rt() { return __builtin_amdgcn_s_memrealtime(); }
__device__ __forceinline__ unsigned f2bf(float f) { unsigned u = __builtin_bit_cast(unsigned, f); return (u + 0x7fffu + ((u >> 16) & 1u)) >> 16; }
__device__ __forceinline__ unsigned pk2(float lo, float hi) { return f2bf(lo) | (f2bf(hi) << 16); }

#define XB_TMO      128
#define XB_XCNT(j)  (256  + 64 * (j))
#define XB_XSUB(j)  (1280 + 64 * (j))
#define XB_XGEN(j)  (2304 + 64 * (j))
#define XB_TOP      3328
#define XB_TOPGEN   3392
#define XCD_BAR_WORDS 3456
#define XB_SPIN_CAP (1u << 18)

__device__ __forceinline__ unsigned xb_ld(unsigned* p)              { return __hip_atomic_load(p, __ATOMIC_RELAXED, __HIP_MEMORY_SCOPE_AGENT); }
__device__ __forceinline__ unsigned xb_add(unsigned* p, unsigned v) { return __hip_atomic_fetch_add(p, v, __ATOMIC_RELAXED, __HIP_MEMORY_SCOPE_AGENT); }
__device__ __forceinline__ unsigned xb_xcc_id() { return (unsigned)__builtin_amdgcn_s_getreg((3 << 11) | 20) & 0xFu; }
#define XB_SPIN(cond, bar) do { unsigned _sp = 0; while (cond) { __builtin_amdgcn_s_sleep(1); \
    if ((++_sp & 255u) == 0u) { if (xb_ld(&(bar)[XB_TMO])) break; if (_sp > XB_SPIN_CAP) { atomicAdd(&(bar)[XB_TMO], 1u); break; } } } } while (0)

struct XcdBarrier {
    unsigned* bar; unsigned x;
    volatile LAS unsigned* st;
};

__device__ __forceinline__ XcdBarrier xcd_barrier_post(unsigned* bar, volatile LAS unsigned* st) {
    XcdBarrier b; b.bar = bar; b.x = xb_xcc_id(); b.st = st;
    if (threadIdx.x == 0) (void)xb_add(&bar[XB_XCNT(b.x)], 1u);
    return b;
}
__device__ __forceinline__ void xcd_barrier_complete(unsigned* bar, unsigned x, unsigned& nloc, unsigned& nx) {
    const unsigned G = gridDim.x * gridDim.y * gridDim.z;
    unsigned sum, cnt, mine, sp = 0u;
    for (;;) {
        sum = 0u; cnt = 0u; mine = 0u;
#pragma unroll
        for (unsigned j = 0; j < 16; ++j) { const unsigned c = xb_ld(&bar[XB_XCNT(j)]); sum += c; cnt += (c > 0u) ? 1u : 0u; mine = (j == x) ? c : mine; }
        if (sum == G) break;
        __builtin_amdgcn_s_sleep(1);
        if ((++sp & 255u) == 0u) { if (xb_ld(&bar[XB_TMO])) break; if (sp > XB_SPIN_CAP) { atomicAdd(&bar[XB_TMO], 1u); break; } }
    }
    nloc = mine > 0u ? mine : 1u; nx = cnt > 0u ? cnt : 1u;
}

__device__ __forceinline__ void xcd_barrier(const XcdBarrier& b) {
    asm volatile("s_waitcnt vmcnt(0)" ::: "memory");
    __syncthreads();
    if (threadIdx.x == 0) {
        unsigned* bar = b.bar;
        __builtin_amdgcn_s_waitcnt(0);
        unsigned nloc = b.st[0], nx = b.st[1];
        if (nloc == 0u) { xcd_barrier_complete(bar, b.x, nloc, nx); b.st[0] = nloc; b.st[1] = nx; }
        const unsigned old = xb_add(&bar[XB_XSUB(b.x)], 1u);
        const unsigned gen = old / nloc;
        if (old + 1u == (gen + 1u) * nloc) {
            __builtin_amdgcn_fence(__ATOMIC_RELEASE, "agent");
            asm volatile("s_waitcnt vmcnt(0)" ::: "memory");
            const unsigned og = xb_add(&bar[XB_TOP], 1u);
            const unsigned tg = og / nx;
            if (og + 1u == (tg + 1u) * nx) xb_add(&bar[XB_TOPGEN], 1u);
            else XB_SPIN(xb_ld(&bar[XB_TOPGEN]) == tg, bar);
            __builtin_amdgcn_fence(__ATOMIC_ACQUIRE, "agent");
            xb_add(&bar[XB_XGEN(b.x)], 1u);
            asm volatile("s_waitcnt vmcnt(0)" ::: "memory");
        } else {
            XB_SPIN(xb_ld(&bar[XB_XGEN(b.x)]) == gen, bar);
            __builtin_amdgcn_fence(__ATOMIC_ACQUIRE, "agent");
            asm volatile("s_waitcnt vmcnt(0)" ::: "memory");
        }
    }
    __syncthreads();
}

struct Frame {
    LAS unsigned char* lds;
    volatile LAS unsigned* MISC;
    gu32* ctl;
    int tid, lane, wave;
    int vcu, G;
};

__device__ __forceinline__ float wave_sum(float v) {
#pragma unroll
    for (int o = 1; o < 64; o <<= 1) v += __shfl_xor(v, o);
    return v;
}

__device__ __forceinline__ int map_in(int n) {
    if (n < 1024) return ((n >> 7) << 8) + (n & 127);
    if (n < 2048) { const int c = n - 1024; return ((c >> 7) << 8) + 128 + (c & 127); }
    if (n < 4096) { const int d = n & 63; const int dp = d < 16 ? (2 * (d & 7) + (d >> 3)) : d; return n - d + dp; }
    if (n < 5120) return n;
    if (n < 6144) { const int c = n - 5120; return 5120 + ((c >> 7) << 8) + (c & 127); }
    { const int c = n - 6144; return 5120 + ((c >> 7) << 8) + 128 + (c & 127); }
}
template <int MAP> __device__ __forceinline__ int maprow(int n) {
    if (MAP == 1) return map_in(n);
    if (MAP == 2) return ((n >> 7) << 8) + (n & 127);
    if (MAP == 3) return ((n >> 7) << 8) + 128 + (n & 127);
    return n;
}
template <int MAP> __device__ __forceinline__ void p0_transpose_item(const float* W, int K, int N, bf16* WT, int ldt, int koff, const float* g, LAS float* scr, int item, int lane) {
    const int nblk = N / 32, kb = item / nblk, nb = item % nblk, k0 = 64 * kb, n0 = 32 * nb;
    float wv[32];
#pragma unroll
    for (int i = 0; i < 32; ++i) { const int kk = 2 * i + (lane >> 5); wv[i] = W[(size_t)(k0 + kk) * N + n0 + (lane & 31)]; }
    if (g) {
#pragma unroll
        for (int i = 0; i < 32; ++i) wv[i] *= g[k0 + 2 * i + (lane >> 5)]; }
#pragma unroll
    for (int i = 0; i < 32; ++i) { const int kk = 2 * i + (lane >> 5); scr[kk * 33 + (lane & 31)] = wv[i]; }
    LDS_WAIT(); asm volatile("" ::: "memory");
    const int c = lane & 7;
#pragma unroll
    for (int j = 0; j < 4; ++j) { const int n = (lane >> 3) + 8 * j; const LAS float* s = scr + (8 * c) * 33 + n;
        v4u o; o.x = pk2(s[0 * 33], s[1 * 33]); o.y = pk2(s[2 * 33], s[3 * 33]); o.z = pk2(s[4 * 33], s[5 * 33]); o.w = pk2(s[6 * 33], s[7 * 33]);
        *(GAS v4u*)(WT + (size_t)maprow<MAP>(n0 + n) * ldt + koff + k0 + 8 * c) = o; }
    LDS_WAIT(); asm volatile("" ::: "memory");
}
template <int NR> __device__ __forceinline__ void p0_rows(const float* xrow, bf16* orow, float* rs, int lane) {
    f32x4 v[NR][4]; float s[NR];
#pragma unroll
    for (int r = 0; r < NR; ++r)
#pragma unroll
        for (int j = 0; j < 4; ++j) v[r][j] = ((const GAS f32x4*)(xrow + (size_t)r * D) + lane)[64 * j];
#pragma unroll
    for (int r = 0; r < NR; ++r) { s[r] = 0.f;
#pragma unroll
        for (int j = 0; j < 4; ++j) s[r] += (v[r][j].x * v[r][j].x + v[r][j].y * v[r][j].y) + (v[r][j].z * v[r][j].z + v[r][j].w * v[r][j].w);
        s[r] = wave_sum(s[r]); }
#pragma unroll
    for (int r = 0; r < NR; ++r) { if (lane == 0) rs[r] = 1.f / sqrtf(s[r] * (1.f / D) + RMS_EPS);
        GAS unsigned long long* o8 = (GAS unsigned long long*)(orow + (size_t)r * D) + lane;
#pragma unroll
        for (int j = 0; j < 4; ++j) o8[64 * j] = (unsigned long long)pk2(v[r][j].x, v[r][j].y) | ((unsigned long long)pk2(v[r][j].z, v[r][j].w) << 32); }
}
__device__ __forceinline__ void rope_entry(int e, float* rope) {
    const int pos = e >> 3, i = e & 7;
    const float invf = i == 0 ? 1.0f : i == 1 ? 0.1939227432012558f : i == 2 ? 0.03760603070259094f : i == 3 ? 0.007292664609849453f : i == 4 ? 0.0014142135623842478f
                     : i == 5 ? 0.00027424818836152554f : i == 6 ? 5.3182957344688475e-05f : 1.0313385246263351e-05f;
    const float angf = (float)pos * invf; const double a = (double)angf;
    const double kq = __builtin_rint(a * 0.63661977236758134308);
    double r = __builtin_fma(-kq, 1.57079632679489655800, a); r = __builtin_fma(-kq, 6.12323399573676603587e-17, r);
    const double r2 = r * r;
    double sp = -7.6471637318198164759e-13; sp = sp * r2 + 1.6059043836821614599e-10; sp = sp * r2 - 2.5052108385441718775e-08; sp = sp * r2 + 2.7557319223985890653e-06;
    sp = sp * r2 - 1.9841269841269841270e-04; sp = sp * r2 + 8.3333333333333333333e-03; sp = sp * r2 - 1.6666666666666666667e-01; const double sn = r + r * r2 * sp;
    double cp = 4.7794773323873852974e-14; cp = cp * r2 - 1.1470745597729724714e-11; cp = cp * r2 + 2.0876756987868098979e-09; cp = cp * r2 - 2.7557319223985890653e-07;
    cp = cp * r2 + 2.4801587301587301587e-05; cp = cp * r2 - 1.3888888888888888889e-03; cp = cp * r2 + 4.1666666666666666667e-02; cp = cp * r2 - 0.5; const double cs = 1.0 + r2 * cp;
    const int q = (int)((long long)kq & 3);
    const double c = q == 0 ? cs : q == 1 ? -sn : q == 2 ? -cs : sn, s = q == 0 ? sn : q == 1 ? cs : q == 2 ? -sn : -cs;
    rope[2 * e] = (float)c; rope[2 * e + 1] = (float)s;
}
struct P0Args { const float *x, *g_mix, *w_in, *w_cpw, *w_apw, *w_out, *g_ffn, *w_fg, *w_fu, *w_fd; bf16 *WIN, *WCA, *WO, *WGU, *WD, *XB; float *rs1, *rope; };
__device__ __forceinline__ void p0_prologue(Frame& F, const P0Args& a) {
    LAS float* scr = (LAS float*)(F.lds + RING_OFF + F.wave * 16384);
    const int gw = F.vcu * NWAVES + F.wave, NGW = F.G * NWAVES;
    constexpr int I_IN = (D / 64) * (INC / 32), I_SQ = (D / 64) * (D / 32), I_GU = (D / 64) * (DFF / 32), I_DN = (DFF / 64) * (D / 32);
    constexpr int NITEMS = I_IN + 3 * I_SQ + 2 * I_GU + I_DN;
    for (int it = gw; it < NITEMS; it += NGW) {
        int r = it;
        if (r < I_IN) { p0_transpose_item<1>(a.w_in, D, INC, a.WIN, D, 0, a.g_mix, scr, r, F.lane); continue; } r -= I_IN;
        if (r < I_SQ) { p0_transpose_item<0>(a.w_cpw, D, D, a.WCA, 2 * D, 0, nullptr, scr, r, F.lane); continue; } r -= I_SQ;
        if (r < I_SQ) { p0_transpose_item<0>(a.w_apw, D, D, a.WCA, 2 * D, D, nullptr, scr, r, F.lane); continue; } r -= I_SQ;
        if (r < I_SQ) { p0_transpose_item<0>(a.w_out, D, D, a.WO, D, 0, nullptr, scr, r, F.lane); continue; } r -= I_SQ;
        if (r < I_GU) { p0_transpose_item<2>(a.w_fg, D, DFF, a.WGU, D, 0, a.g_ffn, scr, r, F.lane); continue; } r -= I_GU;
        if (r < I_GU) { p0_transpose_item<3>(a.w_fu, D, DFF, a.WGU, D, 0, a.g_ffn, scr, r, F.lane); continue; } r -= I_GU;
        p0_transpose_item<0>(a.w_fd, DFF, D, a.WD, DFF, 0, nullptr, scr, r, F.lane);
    }
    for (int m = gw * 4; m < M; m += NGW * 4) p0_rows<4>(a.x + (size_t)m * D, a.XB + (size_t)m * D, a.rs1 + m, F.lane);
    for (int e = (F.vcu * NWAVES + F.wave) * 64 + F.lane; e < SEQ * 8; e += F.G * NWAVES * 64) rope_entry(e, a.rope);
}

#ifdef PROBE_A
#define CSTAMP(k) do { if (F.tid == 0) F.MISC[12 + (k)] = (unsigned)rt(); } while (0)
#else
#define CSTAMP(k) do { } while (0)
#endif
struct ConvArgs { const bf16* U; bf16* CA; const float *wdw, *bdw, *gln, *bln; };
typedef float f32x2 __attribute__((ext_vector_type(2)));
__device__ __forceinline__ void fmac_(float& a, float w, float u) { asm("v_fmac_f32_e32 %0, %1, %2" : "+v"(a) : "v"(w), "v"(u)); }
template <int I> struct ConvLoop {
    static __device__ __forceinline__ void run(float (&a0)[32], float (&a1)[32], const float (&w0)[31], const float (&w1)[31], const LAS unsigned char* up) {
        const unsigned uv = *(const LAS unsigned*)(up + I * 2048);
        const float u0 = __uint_as_float(uv << 16), u1 = __uint_as_float(uv & 0xffff0000u);
        constexpr int OLO = I > 30 ? I - 30 : 0, OHI = I < 31 ? I : 31;
#pragma unroll
        for (int o = OLO; o <= OHI; ++o) { fmac_(a0[o], w0[I - o], u0); fmac_(a1[o], w1[I - o], u1); }
        if ((I & 3) == 3) __builtin_amdgcn_sched_barrier(0);
        ConvLoop<I + 1>::run(a0, a1, w0, w1, up);
    }
};
template <> struct ConvLoop<62> { static __device__ __forceinline__ void run(float (&)[32], float (&)[32], const float (&)[31], const float (&)[31], const LAS unsigned char*) {} };
constexpr int CONV_TILE_BYTES = 62 * 2048, CONV_RED_OFF = CONV_TILE_BYTES, CONV_STAT_OFF = CONV_RED_OFF + 2048;
static_assert(CONV_STAT_OFF + 256 <= RING_BYTES, "conv LDS map");
__device__ __forceinline__ void conv_dma(Frame& F, const ConvArgs& a, int item) {
    const int row0 = item * 32; const bool head = ((row0 & (SEQ - 1)) == 0);
    const unsigned char* gsrc = (const unsigned char*)(a.U + ((size_t)row0 - 30) * D) + F.lane * 16;
    for (int p = head ? 60 + ((F.wave + 4) & 7) : F.wave; p < 124; p += 8)
        __builtin_amdgcn_global_load_lds((const unsigned*)(gsrc + (size_t)p * 1024), (LAS unsigned*)(F.lds + RING_OFF + p * 1024), 16, 0, 0);
    if (head) for (int q = F.tid; q < 60 * 64; q += NWAVES * 64) *(LAS v4u*)(F.lds + RING_OFF + q * 16) = (v4u){0u, 0u, 0u, 0u};
}
#define CONV_BAR() asm volatile("s_waitcnt lgkmcnt(0)\n\ts_barrier" ::: "memory")
__device__ __forceinline__ void conv_item(Frame& F, const ConvArgs& a, int item, int next_item, const float (&w0)[31], const float (&w1)[31]) {
    const int tid = F.tid, lane = F.lane, c0 = 2 * tid, row0 = item * 32;
    CSTAMP(30);
    float a0[32], a1[32];
#pragma unroll
    for (int o = 0; o < 32; ++o) { a0[o] = 0.f; a1[o] = 0.f; }
    asm volatile("s_waitcnt vmcnt(0) lgkmcnt(0)\n\ts_barrier" ::: "memory");
    CSTAMP(31);
    ConvLoop<0>::run(a0, a1, w0, w1, F.lds + RING_OFF + tid * 4);
    CSTAMP(32);
    const f32x2 bd = *(const f32x2*)(a.bdw + c0);
    LAS float* red = (LAS float*)(F.lds + RING_OFF + CONV_RED_OFF);
    LAS float* stat = (LAS float*)(F.lds + RING_OFF + CONV_STAT_OFF);
#define TR_STEP(OFF, N) { const bool up_ = (lane & (OFF)) != 0; _Pragma("unroll") for (int k = 0; k < (N); ++k) { const float send = up_ ? v[k] : v[k + (N)], keep = up_ ? v[k + (N)] : v[k]; v[k] = keep + __shfl_xor(send, (OFF)); } }
#pragma unroll
    for (int pass = 0; pass < 2; ++pass) {
        float v[32];
#pragma unroll
        for (int o = 0; o < 32; ++o) { if (pass == 0) { a0[o] += bd.x; a1[o] += bd.y; v[o] = a0[o] + a1[o]; } else v[o] = a0[o] * a0[o] + a1[o] * a1[o]; }
        TR_STEP(32, 16) TR_STEP(16, 8) TR_STEP(8, 4) TR_STEP(4, 2) TR_STEP(2, 1)
        v[0] += __shfl_xor(v[0], 1);
        if ((lane & 1) == 0) red[F.wave * 64 + pass * 32 + (lane >> 1)] = v[0];
    }
#undef TR_STEP
    CONV_BAR();
    if (next_item >= 0) conv_dma(F, a, next_item);
    if (tid < 32) { float s = 0.f, q = 0.f;
#pragma unroll
        for (int wv = 0; wv < 8; ++wv) { s += red[wv * 64 + tid]; q += red[wv * 64 + 32 + tid]; }
        const float mean = s * (1.f / D), var = q * (1.f / D) - mean * mean;
        stat[tid] = mean; stat[32 + tid] = 1.f / sqrtf(fmaxf(var, 0.f) + LN_EPS); }
    CONV_BAR();
    CSTAMP(33);
    const f32x2 gl = *(const f32x2*)(a.gln + c0), bl = *(const f32x2*)(a.bln + c0);
    bf16* op = a.CA + (size_t)row0 * 2048 + c0;
#pragma unroll
    for (int o = 0; o < 32; ++o) { const float mean = stat[o], rstd = stat[32 + o];
        const float y0 = (a0[o] - mean) * rstd * gl.x + bl.x, y1 = (a1[o] - mean) * rstd * gl.y + bl.y;
        *(unsigned*)op = pg8::cvt_pk_bf16(y0 * pg8::sigm(y0), y1 * pg8::sigm(y1));
        op += 2048; asm volatile("" : "+v"(op)); }
    CONV_BAR();
    CSTAMP(34);
}
#undef CONV_BAR

namespace att {
typedef short bf16x8 __attribute__((ext_vector_type(8)));
typedef short s16x4 __attribute__((ext_vector_type(4)));
typedef float f32x16 __attribute__((ext_vector_type(16)));
typedef short v4i16_t __attribute__((ext_vector_type(4)));
__device__ __forceinline__ int crow(int r, int hi) { return (r & 3) + 8 * (r >> 2) + 4 * hi; }
__device__ __forceinline__ s16x4 vtr(const LAS unsigned char* p) { return __builtin_bit_cast(s16x4, __builtin_amdgcn_ds_read_tr16_b64_v4i16((LAS v4i16_t*)p)); }
#define ATT_MFMA(a, b, c) __builtin_amdgcn_mfma_f32_32x32x16_bf16(a, b, c, 0, 0, 0)
__device__ __forceinline__ void attn_unit(int b, int h, int qb, bf16* CA, const bf16* Kp, const bf16* Vp, const float* gsub, float lam, LAS unsigned char* lds) {
    const int tid = threadIdx.x, lane = tid & 63, r32 = lane & 31, hi = lane >> 5;
    const int wid = __builtin_amdgcn_readfirstlane(tid >> 6), comp = wid >> 2, w4 = wid & 3;
    const int q0 = qb * 128, NT = 2 * qb + 2;
    const size_t rowbase = (size_t)b * SEQ;
    LAS float* wsf = (LAS float*)(lds + 65536) + wid * 32;
    const bf16* Qp = CA + (rowbase + q0 + w4 * 32 + r32) * 2048 + 1024 + h * 128 + comp * 64 + hi * 8;
    bf16x8 qr[4];
#pragma unroll
    for (int d0 = 0; d0 < 4; ++d0) qr[d0] = *(const bf16x8*)(Qp + d0 * 16);
    const unsigned char* Kt = (const unsigned char*)(Kp + (size_t)((b * 8 + h) * 32) * 8192) + tid * 16;
    const unsigned char* Vt = (const unsigned char*)(Vp + (size_t)((b * 8 + h) * 32) * 8192) + tid * 16;
    v4u ks0 = *(const v4u*)(Kt), ks1 = *(const v4u*)(Kt + 8192), vs0 = *(const v4u*)(Vt), vs1 = *(const v4u*)(Vt + 8192);
    { LAS unsigned char* d = lds + tid * 16; *(LAS v4u*)(d) = ks0; *(LAS v4u*)(d + 8192) = ks1; *(LAS v4u*)(d + 16384) = vs0; *(LAS v4u*)(d + 24576) = vs1; }
    __syncthreads();
    f32x16 o[4];
#pragma unroll
    for (int d = 0; d < 4; ++d)
#pragma unroll
        for (int r = 0; r < 16; ++r) o[d][r] = 0.f;
    float mref = -1e30f, l = 0.f;
    const int qrel = w4 * 32 + r32;
    for (int t = 0; t < NT; ++t) {
        const int buf = t & 1; const bool more = (t + 1 < NT);
        if (more) { const size_t go = (size_t)(t + 1) * 16384; ks0 = *(const v4u*)(Kt + go); ks1 = *(const v4u*)(Kt + go + 8192); vs0 = *(const v4u*)(Vt + go); vs1 = *(const v4u*)(Vt + go + 8192); }
        const int jb = t - (NT - 2);
        const bool skip = (jb == 1) && (w4 < 2);
        if (!skip) {
            const LAS unsigned char* kb = lds + buf * 32768 + comp * 8192 + hi * 1024 + r32 * 16;
            f32x16 p0, p1;
#pragma unroll
            for (int r = 0; r < 16; ++r) { p0[r] = 0.f; p1[r] = 0.f; }
#pragma unroll
            for (int d0 = 0; d0 < 4; ++d0) { const bf16x8 a0 = *(const LAS bf16x8*)(kb + d0 * 2048), a1 = *(const LAS bf16x8*)(kb + d0 * 2048 + 512);
                p0 = ATT_MFMA(a0, qr[d0], p0); p1 = ATT_MFMA(a1, qr[d0], p1); }
            if (jb >= 0) { const int kb_ = 64 * jb + 4 * hi;
#pragma unroll
                for (int r = 0; r < 16; ++r) { const int kv = kb_ + (r & 3) + 8 * (r >> 2); if (kv > qrel) p0[r] = -INFINITY; if (kv + 32 > qrel) p1[r] = -INFINITY; } }
            float rm = fmaxf(p0[0], p1[0]);
#pragma unroll
            for (int r = 1; r < 16; ++r) rm = fmaxf(rm, fmaxf(p0[r], p1[r]));
            rm = fmaxf(rm, __shfl_xor(rm, 32));
            if (__any(rm > mref + 8.f)) {
                const float mnew = fmaxf(mref, rm), f = pg8::ex2(mref - mnew); mref = mnew; l *= f;
                if (hi == 0) wsf[r32] = f;
#pragma unroll
                for (int r = 0; r < 16; ++r) { const float fr_ = wsf[crow(r, hi)];
#pragma unroll
                    for (int d = 0; d < 4; ++d) o[d][r] *= fr_; }
            }
            float sacc = 0.f;
#pragma unroll
            for (int r = 0; r < 16; ++r) { p0[r] = pg8::ex2(p0[r] - mref); p1[r] = pg8::ex2(p1[r] - mref); sacc += p0[r] + p1[r]; }
            l += sacc;
            v4u pw[4];
#pragma unroll
            for (int k = 0; k < 2; ++k) {
                pw[k] = (v4u){pg8::cvt_pk_bf16(p0[8 * k], p0[8 * k + 1]), pg8::cvt_pk_bf16(p0[8 * k + 2], p0[8 * k + 3]), pg8::cvt_pk_bf16(p0[8 * k + 4], p0[8 * k + 5]), pg8::cvt_pk_bf16(p0[8 * k + 6], p0[8 * k + 7])};
                pw[2 + k] = (v4u){pg8::cvt_pk_bf16(p1[8 * k], p1[8 * k + 1]), pg8::cvt_pk_bf16(p1[8 * k + 2], p1[8 * k + 3]), pg8::cvt_pk_bf16(p1[8 * k + 4], p1[8 * k + 5]), pg8::cvt_pk_bf16(p1[8 * k + 6], p1[8 * k + 7])}; }
            const LAS unsigned char* vb = lds + buf * 32768 + 16384 + (4 * hi + ((lane & 15) >> 2)) * 64 + ((lane >> 4) & 1) * 32 + (lane & 3) * 8;
#pragma unroll
            for (int d = 0; d < 4; ++d)
#pragma unroll
                for (int k = 0; k < 4; ++k) { const s16x4 lo = vtr(vb + (d * 4 + k) * 1024), hh = vtr(vb + (d * 4 + k) * 1024 + 512);
                    const bf16x8 vf = {lo[0], lo[1], lo[2], lo[3], hh[0], hh[1], hh[2], hh[3]};
                    o[d] = ATT_MFMA(__builtin_bit_cast(bf16x8, pw[k]), vf, o[d]); }
        }
        if (more) { LAS unsigned char* d = lds + (buf ^ 1) * 32768 + tid * 16; *(LAS v4u*)(d) = ks0; *(LAS v4u*)(d + 8192) = ks1; *(LAS v4u*)(d + 16384) = vs0; *(LAS v4u*)(d + 24576) = vs1; }
        __syncthreads();
    }
    l += __shfl_xor(l, 32);
    { float inv = 1.f / l; if (comp == 1) inv *= lam; if (hi == 0) wsf[r32] = inv; }
#pragma unroll
    for (int r = 0; r < 16; ++r) { const float ri = wsf[crow(r, hi)];
#pragma unroll
        for (int d = 0; d < 4; ++d) o[d][r] *= ri; }
    LAS f32x4* X = (LAS f32x4*)lds;
    if (comp == 1) {
#pragma unroll
        for (int d = 0; d < 4; ++d)
#pragma unroll
            for (int rq = 0; rq < 4; ++rq) X[((w4 * 4 + d) * 4 + rq) * 64 + lane] = (f32x4){o[d][4 * rq], o[d][4 * rq + 1], o[d][4 * rq + 2], o[d][4 * rq + 3]};
    }
    __syncthreads();
    if (comp == 0) {
        float ss[16];
#pragma unroll
        for (int r = 0; r < 16; ++r) ss[r] = 0.f;
#pragma unroll
        for (int d = 0; d < 4; ++d)
#pragma unroll
            for (int rq = 0; rq < 4; ++rq) { const f32x4 x = X[((w4 * 4 + d) * 4 + rq) * 64 + lane];
#pragma unroll
                for (int e = 0; e < 4; ++e) { const float y = o[d][4 * rq + e] - x[e]; o[d][4 * rq + e] = y; ss[4 * rq + e] += y * y; } }
#pragma unroll
        for (int r = 0; r < 16; ++r) {
#pragma unroll
            for (int off = 1; off < 32; off <<= 1) ss[r] += __shfl_xor(ss[r], off);
            ss[r] = 1.f / sqrtf(ss[r] * (1.f / 128.f) + RMS_EPS); }
        float gs[4];
#pragma unroll
        for (int d = 0; d < 4; ++d) gs[d] = gsub[32 * d + r32] * 0.8f;
        bf16* Op = CA + (rowbase + q0 + w4 * 32) * 2048 + 1024 + h * 128 + r32;
#pragma unroll
        for (int r = 0; r < 16; ++r) { bf16* rp = Op + (size_t)crow(r, hi) * 2048;
#pragma unroll
            for (int d = 0; d < 4; ++d) rp[32 * d] = (bf16)f2bf(o[d][r] * ss[r] * gs[d]); }
    }
    __syncthreads();
}
#undef ATT_MFMA
}

__device__ __forceinline__ void final_rows(Frame& F, float* out, const float* part, const float* gfin) {
    const int gw = F.vcu * NWAVES + F.wave, NGW = F.G * NWAVES;
    f32x4 g[4];
#pragma unroll
    for (int j = 0; j < 4; ++j) g[j] = *((const GAS f32x4*)gfin + F.lane + 64 * j);
    for (int m = gw; m < M; m += NGW) {
        GAS f32x4* xr = (GAS f32x4*)(out + (size_t)m * D) + F.lane;
        f32x4 v[4];
#pragma unroll
        for (int j = 0; j < 4; ++j) v[j] = xr[64 * j];
        const f32x4 p0 = *(const f32x4*)(part + (size_t)m * 16), p1 = *(const f32x4*)(part + (size_t)m * 16 + 4), p2 = *(const f32x4*)(part + (size_t)m * 16 + 8), p3 = *(const f32x4*)(part + (size_t)m * 16 + 12);
        const float s = (((p0[0] + p0[1]) + (p0[2] + p0[3])) + ((p1[0] + p1[1]) + (p1[2] + p1[3]))) + (((p2[0] + p2[1]) + (p2[2] + p2[3])) + ((p3[0] + p3[1]) + (p3[2] + p3[3])));
        const float rs = 1.f / sqrtf(s * (1.f / D) + RMS_EPS);
#pragma unroll
        for (int j = 0; j < 4; ++j) xr[64 * j] = v[j] * rs * g[j];
    }
}

struct Args { const float* in[21]; float* out; unsigned char* ws; int ph_lo, ph_hi, li, pad; };
__global__ void __launch_bounds__(NWAVES * 64, 2) hyb_fwd(Args args) {
    extern __shared__ __attribute__((aligned(16))) unsigned char lds[];
    Frame F;
    F.lds = (LAS unsigned char*)lds;
    F.MISC = (volatile LAS unsigned*)(F.lds + MISC_OFF);
    F.tid = threadIdx.x; F.lane = F.tid & 63; F.wave = __builtin_amdgcn_readfirstlane(F.tid >> 6);
    F.G = gridDim.x; { const int bx = blockIdx.x; F.vcu = (F.G % 8 == 0) ? (bx % 8) * (F.G / 8) + bx / 8 : bx; }
    unsigned char* ws = args.ws;
    F.ctl = (gu32*)(ws + WS_CTL);
#define IN_(k) (args.in[k])
#define x_ IN_(0)
#define g_mix IN_(1)
#define w_in IN_(2)
#define b_gate IN_(3)
#define w_dw IN_(4)
#define b_dw IN_(5)
#define g_cln IN_(6)
#define b_cln IN_(7)
#define w_cpw IN_(8)
#define lq1 IN_(9)
#define lk1 IN_(10)
#define lq2 IN_(11)
#define lk2 IN_(12)
#define g_sub IN_(13)
#define w_apw IN_(14)
#define w_out IN_(15)
#define g_ffn IN_(16)
#define w_fg IN_(17)
#define w_fu IN_(18)
#define w_fd IN_(19)
#define g_fin IN_(20)
#define out (args.out)
#define WIN ((bf16*)(ws + WS_WIN))
#define WCA ((bf16*)(ws + WS_WCA))
#define WO ((bf16*)(ws + WS_WO))
#define WGU ((bf16*)(ws + WS_WGU))
#define WD ((bf16*)(ws + WS_WD))
#define ROPE ((float*)(ws + WS_ROPE))
#define RS1 ((float*)(ws + WS_RS1))
#define PART1 ((float*)(ws + WS_PART1))
#define PART2 ((float*)(ws + WS_PART2))
#define XB ((bf16*)(ws + WS_XB))
#define U ((bf16*)(ws + WS_U))
#define CA ((bf16*)(ws + WS_CA))
#define VP ((bf16*)(ws + WS_V))
#define KP ((bf16*)(ws + WS_K))
#define MERGED ((bf16*)(ws + WS_MERGED))
#define X1B ((bf16*)(ws + WS_X1B))
#define FF ((bf16*)(ws + WS_FF))
#define GATES ((bf16*)out)

    for (int u = F.tid; u < (LDS_BYTES - LDSCTL_OFF) / 4; u += NWAVES * 64) ((LAS unsigned*)(F.lds + LDSCTL_OFF))[u] = 0u;
    __syncthreads();
    XcdBarrier bar; bar.bar = (unsigned*)(F.ctl + CW_BAR); bar.x = 0; bar.st = nullptr;
    if (N_LAUNCHES != PER_PHASE) bar = xcd_barrier_post((unsigned*)(F.ctl + CW_BAR), F.MISC + 8);
#define GRID_BAR() do { if (N_LAUNCHES != PER_PHASE) xcd_barrier(bar); } while (0)
    const int lo = args.ph_lo, hi = args.ph_hi;
#ifndef PH_MASK
#define PH_MASK 0xff
#endif
#define IN(k) (((PH_MASK >> (k)) & 1) && lo <= (k) && (k) < hi)
#define BOTH(k) (IN(k) && IN((k) + 1))
#ifdef PROBE_A
#define STAMP(k) do { if (F.tid == 0) F.MISC[12 + (k)] = (unsigned)rt(); } while (0)
#else
#define STAMP(k) do { } while (0)
#endif
    STAMP(0);

    if (IN(0)) {
        P0Args a{x_, g_mix, w_in, w_cpw, w_apw, w_out, g_ffn, w_fg, w_fu, w_fd, WIN, WCA, WO, WGU, WD, XB, RS1, ROPE};
        p0_prologue(F, a);
        if (BOTH(0)) GRID_BAR();
        STAMP(1);
    }
    if (IN(1)) {
        pg8::Gemm g{XB, WIN, M, INC, D}; pg8::StaticOrder S; S.init(M, INC, F.G, (int)blockIdx.x);
        pg8::EpiIn E{U, CA, KP, VP, GATES, RS1, b_gate, ROPE};
        pg8::gemm_phase<pg8::EpiIn, pg8::StaticOrder, true, true>(F.lds + RING_OFF, g, S, E);
        if (BOTH(1)) GRID_BAR();
        STAMP(2);
    }
    if (IN(2)) {
#ifndef NO_CONV
        { ConvArgs ca{U, CA, w_dw, b_dw, g_cln, b_cln};
          float w0[31], w1[31];
          { const float* wp = w_dw + 2 * F.tid;
            _Pragma("unroll") for (int j = 0; j < 31; ++j) { const f32x2 t = *(const f32x2*)wp; w0[j] = t.x; w1[j] = t.y; wp += D; asm volatile("" : "+v"(wp)); } }
          _Pragma("nounroll") for (int it = F.vcu * 4; it < M / 32; it += F.G * 4) { conv_dma(F, ca, it);
              _Pragma("nounroll") for (int k = 0; k < 4; ++k) conv_item(F, ca, it + k, k < 3 ? it + k + 1 : -1, w0, w1); }
          asm volatile("s_waitcnt vmcnt(0)" ::: "memory"); __syncthreads(); }
#endif
        STAMP(10);
#ifndef NO_ATTN
        const float d1 = wave_sum(lq1[F.lane] * lk1[F.lane]), d2 = wave_sum(lq2[F.lane] * lk2[F.lane]);
        const float lam = expf(d1) - expf(d2) + 0.2f;
        for (int v = F.vcu; v < 256; v += F.G) {
            const int bh = v >> 1, sub = v & 1;
            for (int i = 0; i < 8; ++i) { const int k = i >> 1; const int qb = (i & 1) ? (2 * k + sub) : (15 - 2 * k - sub);
                att::attn_unit(bh >> 3, bh & 7, qb, CA, KP, VP, g_sub, lam, F.lds + RING_OFF); }
        }
#endif
        if (BOTH(2)) GRID_BAR();
        STAMP(3);
    }
    if (IN(3)) {
        pg8::Gemm g{CA, WCA, M, D, 2 * D}; pg8::StaticOrder S; S.init(M, D, F.G, (int)blockIdx.x);
        pg8::EpiMerge E{GATES, MERGED};
        pg8::gemm_phase<pg8::EpiMerge, pg8::StaticOrder, true, true>(F.lds + RING_OFF, g, S, E);
        if (BOTH(3)) GRID_BAR();
        STAMP(4);
    }
    if (IN(4)) {
        pg8::Gemm g{MERGED, WO, M, D, D}; pg8::StaticOrder S; S.init(M, D, F.G, (int)blockIdx.x);
        pg8::EpiResidB E{XB, X1B, PART1};
        pg8::gemm_phase<pg8::EpiResidB, pg8::StaticOrder, true, true>(F.lds + RING_OFF, g, S, E);
        if (BOTH(4)) GRID_BAR();
        STAMP(5);
    }
    if (IN(5)) {
        pg8::Gemm g{X1B, WGU, M, 2 * DFF, D}; pg8::StaticOrder S; S.init(M, 2 * DFF, F.G, (int)blockIdx.x);
        pg8::EpiUp E{PART1, FF, DFF};
        pg8::gemm_phase<pg8::EpiUp, pg8::StaticOrder, true, true>(F.lds + RING_OFF, g, S, E);
        if (BOTH(5)) GRID_BAR();
        STAMP(6);
    }
    if (IN(6)) {
        pg8::Gemm g{FF, WD, M, D, DFF}; pg8::StaticOrder S; S.init(M, D, F.G, (int)blockIdx.x);
        pg8::EpiResidF E{X1B, out, PART2};
        pg8::gemm_phase<pg8::EpiResidF, pg8::StaticOrder, true, true>(F.lds + RING_OFF, g, S, E);
        if (BOTH(6)) GRID_BAR();
        STAMP(7);
    }
    if (IN(7)) final_rows(F, out, PART2, g_fin);
#ifdef PROBE_A
    STAMP(8);
    if (blockIdx.x == 0 && F.tid == 0) { asm volatile("s_waitcnt vmcnt(0) lgkmcnt(0)" ::: "memory"); { const float t01 = (float)(F.MISC[12 + PROBE_B] - F.MISC[12 + PROBE_A]) * 0.1f; out[0] = floorf(t01 * (1.0f / PROBE_UNIT)) + 0.5f; } }
#endif
#undef IN
#undef BOTH
#undef GRID_BAR
#undef STAMP
#undef IN_
#undef x_
#undef g_mix
#undef w_in
#undef b_gate
#undef w_dw
#undef b_dw
#undef g_cln
#undef b_cln
#undef w_cpw
#undef lq1
#undef lk1
#undef lq2
#undef lk2
#undef g_sub
#undef w_apw
#undef w_out
#undef g_ffn
#undef w_fg
#undef w_fu
#undef w_fd
#undef g_fin
#undef out
#undef WIN
#undef WCA
#undef WO
#undef WGU
#undef WD
#undef ROPE
#undef RS1
#undef PART1
#undef PART2
#undef XB
#undef U
#undef CA
#undef VP
#undef KP
#undef MERGED
#undef X1B
#undef FF
#undef GATES
}

extern "C" void kernel_launch(void* const* d_in, const int* in_sizes, int n_in, void* d_out, int out_size, void* d_ws, size_t ws_size, hipStream_t stream) {
    static int grid = 0;
    if (grid == 0) {
        if (n_in != 21 || in_sizes[0] != M * D || out_size != M * D || ws_size < WS_END) { fprintf(stderr, "kernel_launch: unexpected problem: n_in %d in0 %d out %d ws %zu; nothing launched\n", n_in, n_in > 0 ? in_sizes[0] : -1, out_size, ws_size); grid = -1; return; }
        int dev = 0, cus = 0, per_cu = 0;
        if (hipGetDevice(&dev) != hipSuccess || hipDeviceGetAttribute(&cus, hipDeviceAttributeMultiprocessorCount, dev) != hipSuccess) { fprintf(stderr, "kernel_launch: device query failed\n"); grid = -1; return; }
        if (hipFuncSetAttribute((const void*)hyb_fwd, hipFuncAttributeMaxDynamicSharedMemorySize, LDS_BYTES) != hipSuccess) { fprintf(stderr, "kernel_launch: hipFuncSetAttribute failed\n"); grid = -1; return; }
        if (hipOccupancyMaxActiveBlocksPerMultiprocessor(&per_cu, (const void*)hyb_fwd, NWAVES * 64, LDS_BYTES) != hipSuccess || per_cu < 1)
            fprintf(stderr, "kernel_launch: note: occupancy query reports %d workgroups per CU\n", per_cu);
        (void)hipGetLastError();
        grid = cus;
        if (grid > 256) grid = 256;
    }
    if (grid < 0) return;
    if (hipMemsetAsync((char*)d_ws + WS_CTL, 0, CTL_ZERO_BYTES, stream) != hipSuccess) { fprintf(stderr, "kernel_launch: hipMemsetAsync failed\n"); return; }
    Args a{};
    for (int i = 0; i < 21; ++i) a.in[i] = (const float*)d_in[i];
    a.out = (float*)d_out; a.ws = (unsigned char*)d_ws;
    if (N_LAUNCHES == 1) { a.ph_lo = 0; a.ph_hi = PER_PHASE; a.li = 0; hipLaunchKernelGGL(hyb_fwd, dim3(grid), dim3(NWAVES * 64), LDS_BYTES, stream, a); }
    else for (int li = 0; li < PER_PHASE; ++li) { a.ph_lo = li; a.ph_hi = li + 1; a.li = li; hipLaunchKernelGGL(hyb_fwd, dim3(grid), dim3(NWAVES * 64), LDS_BYTES, stream, a); }
    const hipError_t le = hipPeekAtLastError();
    if (le != hipSuccess) fprintf(stderr, "kernel_launch: launch failed: %s\n", hipGetErrorName(le));
}
```

```cpp
#include <hip/hip_runtime.h>
#include <cstdio>
#include <cstdint>
namespace pg8 {
#define PG8_LAS __attribute__((address_space(3)))
typedef unsigned short bf16_t;
typedef short bf16x8 __attribute__((ext_vector_type(8)));
typedef float f32x4 __attribute__((ext_vector_type(4)));
typedef unsigned u32x4 __attribute__((ext_vector_type(4)));
constexpr int BM = 256, BK = 64, HALF = 128, HTB = HALF * BK * 2  , STAGE_BYTES = 8 * HTB, NXCD = 8, WGM = 8;

__host__ __device__ __forceinline__ int lds_byte(int r, int c) { const int st = (r >> 4) * 2 + (c >> 5), rr = r & 15, cc = c & 31, ob = rr * 64 + cc * 2; return st * 1024 + (ob ^ (((ob >> 9) & 1) << 5)); }
__host__ __device__ __forceinline__ void stage_rc(int b, int& R, int& C) { const int st = b / 1024, sb = b % 1024, swz = sb ^ (((sb >> 9) & 1) << 5); R = (st >> 1) * 16 + swz / 64; C = (st & 1) * 32 + (swz % 64) / 2; }
__host__ __device__ __forceinline__ int perm32(int rho) { const int n = rho >> 4, i = rho & 15; return 8 * (i >> 2) + 4 * n + (i & 3); }

struct Unit { int pm, pn; };
struct Gemm { const bf16_t* A; const bf16_t* Bt; int M, N, K; };

struct StaticOrder {
    int nM, nN, nwg, G, c;
    __host__ __device__ void init(int M, int N, int G_, int c_) { nM = M / BM; nN = N / BM; nwg = nM * nN; G = G_; c = c_; }
    __host__ __device__ bool next(int i, Unit& u) const {
        const long L = (long)i * G + c; if (L >= nwg) return false;
        int wgid = (int)L; { const int q = nwg / NXCD, r = nwg % NXCD, xcd = wgid % NXCD, off = wgid / NXCD; wgid = (xcd < r ? xcd * (q + 1) : r * (q + 1) + (xcd - r) * q) + off; }
        const int nig = WGM * nN, gid = wgid / nig, fm = gid * WGM, gsz = (nM - fm) < WGM ? (nM - fm) : WGM;
        u.pm = fm + ((wgid % nig) % gsz); u.pn = (wgid % nig) / gsz; return true;
    }
    __device__ __forceinline__ void a_ready(const Unit&) const {}
    __device__ __forceinline__ void done(const Unit&) const {}
};

__device__ __forceinline__ unsigned cvt_pk_bf16(float lo, float hi) { unsigned r; asm volatile("v_cvt_pk_bf16_f32 %0, %1, %2" : "=v"(r) : "v"(lo), "v"(hi)); return r; }
__device__ __forceinline__ float bf_lo(unsigned w) { return __uint_as_float(w << 16); }
__device__ __forceinline__ float bf_hi(unsigned w) { return __uint_as_float(w & 0xffff0000u); }
constexpr float LOG2E = 1.4426950408889634f;
__device__ __forceinline__ float ex2(float x) { return __builtin_amdgcn_exp2f(x); }
__device__ __forceinline__ float rcpf_(float x) { return __builtin_amdgcn_rcpf(x); }
__device__ __forceinline__ float sigm(float x) { return rcpf_(1.f + ex2(-x * LOG2E)); }
__device__ __forceinline__ u32x4 pack8(const f32x4 a, const f32x4 b) { u32x4 w; w.x = cvt_pk_bf16(a[0], a[1]); w.y = cvt_pk_bf16(a[2], a[3]); w.z = cvt_pk_bf16(b[0], b[1]); w.w = cvt_pk_bf16(b[2], b[3]); return w; }

constexpr int SEQ_ = 2048;
constexpr float QSCALE = 0.125f * 1.4426950408889634f;

struct EpiIn {
    static constexpr bool PERM = true, AFTER_DRAIN = false, MID = false;
    bf16_t* U; bf16_t* CA; bf16_t* Kp; bf16_t* Vp; bf16_t* G; const float* rs1; const float* bgate; const float* rope;
    __device__ __forceinline__ void operator()(const f32x4 (&acc)[2][2][4][2], const Unit& u, int wr, int wc, int fr, int fq) const {
        const int pn = u.pn, rowb = u.pm * BM + wr * 64 + fr;
        if (pn < 8) {
            bf16_t* base = U + pn * 128 + wc * 32 + fq * 8;
#pragma unroll
            for (int ai = 0; ai < 2; ++ai)
#pragma unroll
                for (int m = 0; m < 4; ++m) { const int r = rowb + ai * HALF + m * 16; const float rs = rs1[r]; f32x4 o[2];
#pragma unroll
                    for (int n = 0; n < 2; ++n) { const f32x4 a = acc[ai][0][m][n] * rs, g = acc[ai][1][m][n] * rs;
#pragma unroll
                        for (int e = 0; e < 4; ++e) o[n][e] = a[e] * sigm(g[e]); }
                    *(u32x4*)(base + (size_t)r * 1024) = pack8(o[0], o[1]); }
        } else if (pn < 16) {
            const bool isq = pn < 12; const bool dorope = ((wc & 1) == 0) && (fq < 2);
#pragma unroll
            for (int ai = 0; ai < 2; ++ai)
#pragma unroll
                for (int m = 0; m < 4; ++m) { const int r = rowb + ai * HALF + m * 16; const float rs = rs1[r]; const int pos = r & (SEQ_ - 1);
                    f32x4 cs0 = {1.f, 0.f, 1.f, 0.f}, cs1 = {1.f, 0.f, 1.f, 0.f};
                    if (dorope) { const float* rp = rope + ((size_t)pos * 8 + 4 * fq) * 2; cs0 = *(const f32x4*)rp; cs1 = *(const f32x4*)(rp + 4); }
#pragma unroll
                    for (int bj = 0; bj < 2; ++bj) { f32x4 v0 = acc[ai][bj][m][0] * rs, v1 = acc[ai][bj][m][1] * rs;
                        { const float a = v0[0], b = v0[1], c = v0[2], d = v0[3];
                          v0[0] = a * cs0[0] - b * cs0[1]; v0[1] = b * cs0[0] + a * cs0[1]; v0[2] = c * cs0[2] - d * cs0[3]; v0[3] = d * cs0[2] + c * cs0[3]; }
                        { const float a = v1[0], b = v1[1], c = v1[2], d = v1[3];
                          v1[0] = a * cs1[0] - b * cs1[1]; v1[1] = b * cs1[0] + a * cs1[1]; v1[2] = c * cs1[2] - d * cs1[3]; v1[3] = d * cs1[2] + c * cs1[3]; }
                        if (isq) { v0 = v0 * QSCALE; v1 = v1 * QSCALE;
                            *(u32x4*)(CA + (size_t)r * 2048 + 1024 + (pn - 8) * 256 + bj * HALF + wc * 32 + fq * 8) = pack8(v0, v1);
                        } else { const int b_ = r >> 11, tile = pos >> 6, row = pos & 63, h = 2 * (pn - 12) + bj, comp = wc >> 1, chunk = 4 * (wc & 1) + fq;
                            *(u32x4*)(Kp + ((size_t)((((b_ * 8 + h) * 32 + tile) * 2 + comp) * 8 + chunk) * 64 + row) * 8) = pack8(v0, v1); } } }
        } else if (pn < 20) {
#pragma unroll
            for (int ai = 0; ai < 2; ++ai)
#pragma unroll
                for (int m = 0; m < 4; ++m) { const int r = rowb + ai * HALF + m * 16; const float rs = rs1[r]; const int pos = r & (SEQ_ - 1), b_ = r >> 11, tile = pos >> 6, ks = (pos & 63) >> 4, r16 = pos & 15;
#pragma unroll
                    for (int bj = 0; bj < 2; ++bj) { const int h = 2 * (pn - 16) + bj; const f32x4 v0 = acc[ai][bj][m][0] * rs, v1 = acc[ai][bj][m][1] * rs;
                        *(u32x4*)(Vp + ((size_t)(((b_ * 8 + h) * 32 + tile) * 16 + wc * 4 + ks) * 16 + r16) * 32 + fq * 8) = pack8(v0, v1); } }
        } else {
            const int ch = (pn - 20) * 128 + wc * 32 + fq * 8;
            const f32x4 bc0 = *(const f32x4*)(bgate + ch), bc1 = *(const f32x4*)(bgate + ch + 4), ba0 = *(const f32x4*)(bgate + 1024 + ch), ba1 = *(const f32x4*)(bgate + 1024 + ch + 4);
#pragma unroll
            for (int ai = 0; ai < 2; ++ai)
#pragma unroll
                for (int m = 0; m < 4; ++m) { const int r = rowb + ai * HALF + m * 16; const float rs = rs1[r]; f32x4 rt[2], ga[2];
#pragma unroll
                    for (int n = 0; n < 2; ++n) { const f32x4 xc = acc[ai][0][m][n] * rs + (n ? bc1 : bc0), xa = acc[ai][1][m][n] * rs + (n ? ba1 : ba0);
#pragma unroll
                        for (int e = 0; e < 4; ++e) { const float ea = ex2(fminf(-xa[e] * LOG2E, 80.f)), ec = ex2(-xc[e] * LOG2E); ga[n][e] = rcpf_(1.f + ea); rt[n][e] = (1.f + ea) * rcpf_(1.f + ec); } }
                    *(u32x4*)(G + (size_t)r * 2048 + ch) = pack8(rt[0], rt[1]);
                    *(u32x4*)(G + (size_t)r * 2048 + 1024 + ch) = pack8(ga[0], ga[1]); }
        }
    }
};

struct EpiMerge {
    static constexpr bool PERM = true, AFTER_DRAIN = false, MID = true;
    const bf16_t* G; bf16_t* O;
    __device__ __forceinline__ void mid(f32x4 (&acc)[2][2][4][2], const Unit& u, int wr, int wc, int fr, int fq) const {
        asm volatile("" : "+v"(fr), "+v"(fq));
        const int rowb = u.pm * BM + wr * 64 + fr, col = u.pn * BM + wc * 32 + fq * 8;
#pragma unroll
        for (int ai = 0; ai < 2; ++ai)
#pragma unroll
            for (int m = 0; m < 4; ++m) { const bf16_t* gp = G + (size_t)(rowb + ai * HALF + m * 16) * 2048 + col;
#pragma unroll
                for (int bj = 0; bj < 2; ++bj) { const u32x4 w = *(const u32x4*)(gp + bj * HALF);
                    acc[ai][bj][m][0] *= (f32x4){bf_lo(w.x), bf_hi(w.x), bf_lo(w.y), bf_hi(w.y)}; acc[ai][bj][m][1] *= (f32x4){bf_lo(w.z), bf_hi(w.z), bf_lo(w.w), bf_hi(w.w)}; }
                if (m & 1) asm volatile("" ::: "memory"); }
    }
    __device__ __forceinline__ void operator()(const f32x4 (&acc)[2][2][4][2], const Unit& u, int wr, int wc, int fr, int fq) const {
        const int rowb = u.pm * BM + wr * 64 + fr, col = u.pn * BM + wc * 32 + fq * 8;
#pragma unroll
        for (int ai = 0; ai < 2; ++ai)
#pragma unroll
            for (int m = 0; m < 4; ++m) { const int r = rowb + ai * HALF + m * 16; const bf16_t* gp = G + (size_t)r * 2048 + 1024 + col;
#pragma unroll
                for (int bj = 0; bj < 2; ++bj) { const u32x4 w = *(const u32x4*)(gp + bj * HALF);
                    const f32x4 v0 = acc[ai][bj][m][0] * (f32x4){bf_lo(w.x), bf_hi(w.x), bf_lo(w.y), bf_hi(w.y)}, v1 = acc[ai][bj][m][1] * (f32x4){bf_lo(w.z), bf_hi(w.z), bf_lo(w.w), bf_hi(w.w)};
                    *(u32x4*)(O + (size_t)r * 1024 + col + bj * HALF) = pack8(v0, v1); } }
    }
};

struct EpiResidB {
    static constexpr bool PERM = true, AFTER_DRAIN = false, MID = false;
    const bf16_t* base; bf16_t* ob; float* part;
    __device__ __forceinline__ void operator()(const f32x4 (&acc)[2][2][4][2], const Unit& u, int wr, int wc, int fr, int fq) const {
        const int rowb = u.pm * BM + wr * 64 + fr, col0 = u.pn * BM + wc * 32 + 8 * fq;
#pragma unroll
        for (int ai = 0; ai < 2; ++ai)
#pragma unroll
            for (int m = 0; m < 4; ++m) { const int r = rowb + ai * HALF + m * 16; const size_t off = (size_t)r * 1024 + col0; float ss = 0.f;
#pragma unroll
                for (int bj = 0; bj < 2; ++bj) { const u32x4 w = *(const u32x4*)(base + off + bj * HALF);
                    const f32x4 v0 = acc[ai][bj][m][0] + (f32x4){bf_lo(w.x), bf_hi(w.x), bf_lo(w.y), bf_hi(w.y)}, v1 = acc[ai][bj][m][1] + (f32x4){bf_lo(w.z), bf_hi(w.z), bf_lo(w.w), bf_hi(w.w)};
                    ss += ((v0[0] * v0[0] + v0[1] * v0[1]) + (v0[2] * v0[2] + v0[3] * v0[3])) + ((v1[0] * v1[0] + v1[1] * v1[1]) + (v1[2] * v1[2] + v1[3] * v1[3]));
                    *(u32x4*)(ob + off + bj * HALF) = pack8(v0, v1); }
                ss += __shfl_xor(ss, 16); ss += __shfl_xor(ss, 32);
                if (fq == 0) part[(size_t)r * 16 + u.pn * 4 + wc] = ss; }
    }
};
struct EpiResidF {
    static constexpr bool PERM = true, AFTER_DRAIN = false, MID = false;
    const bf16_t* base; float* out; float* part;
    __device__ __forceinline__ void operator()(const f32x4 (&acc)[2][2][4][2], const Unit& u, int wr, int wc, int fr, int fq) const {
        const int rowb = u.pm * BM + wr * 64 + fr, col0 = u.pn * BM + wc * 32 + 8 * fq;
#pragma unroll
        for (int ai = 0; ai < 2; ++ai)
#pragma unroll
            for (int m = 0; m < 4; ++m) { const int r = rowb + ai * HALF + m * 16; const size_t off = (size_t)r * 1024 + col0; float ss = 0.f;
#pragma unroll
                for (int bj = 0; bj < 2; ++bj) { const u32x4 w = *(const u32x4*)(base + off + bj * HALF);
                    const f32x4 v0 = acc[ai][bj][m][0] + (f32x4){bf_lo(w.x), bf_hi(w.x), bf_lo(w.y), bf_hi(w.y)}, v1 = acc[ai][bj][m][1] + (f32x4){bf_lo(w.z), bf_hi(w.z), bf_lo(w.w), bf_hi(w.w)};
                    ss += ((v0[0] * v0[0] + v0[1] * v0[1]) + (v0[2] * v0[2] + v0[3] * v0[3])) + ((v1[0] * v1[0] + v1[1] * v1[1]) + (v1[2] * v1[2] + v1[3] * v1[3]));
                    *(f32x4*)(out + off + bj * HALF) = v0; *(f32x4*)(out + off + bj * HALF + 4) = v1; }
                ss += __shfl_xor(ss, 16); ss += __shfl_xor(ss, 32);
                if (fq == 0) part[(size_t)r * 16 + u.pn * 4 + wc] = ss; }
    }
};

struct EpiUp {
    static constexpr bool PERM = true, AFTER_DRAIN = false, MID = false;
    const float* part; bf16_t* FF; int ldf;
    __device__ __forceinline__ void operator()(const f32x4 (&acc)[2][2][4][2], const Unit& u, int wr, int wc, int fr, int fq) const {
        const int rowb = u.pm * BM + wr * 64 + fr; bf16_t* base = FF + u.pn * 128 + wc * 32 + fq * 8;
#pragma unroll
        for (int ai = 0; ai < 2; ++ai)
#pragma unroll
            for (int m = 0; m < 4; ++m) { const int r = rowb + ai * HALF + m * 16; const f32x4 pv = *(const f32x4*)(part + (size_t)r * 16 + 4 * fq);
                float s = (pv[0] + pv[1]) + (pv[2] + pv[3]); s += __shfl_xor(s, 16); s += __shfl_xor(s, 32);
                const float rs = 1.0f / sqrtf(s * (1.0f / 1024.0f) + 1e-6f); f32x4 o[2];
#pragma unroll
                for (int n = 0; n < 2; ++n) { const f32x4 g = acc[ai][0][m][n] * rs, up = acc[ai][1][m][n] * rs;
#pragma unroll
                    for (int e = 0; e < 4; ++e) o[n][e] = g[e] * sigm(g[e]) * up[e]; }
                *(u32x4*)(base + (size_t)r * ldf) = pack8(o[0], o[1]); }
    }
};

template <class Epi, class Sched, bool ALIGN_EPI = false, bool SP2 = false>
__device__ __forceinline__ void gemm_phase(PG8_LAS unsigned char* lds, const Gemm g, const Sched& S, const Epi& E) {
    const int tid = threadIdx.x, wid = __builtin_amdgcn_readfirstlane(tid >> 6), lane = tid & 63, wr = wid >> 2, wc = wid & 3, fr = lane & 15, fq = lane >> 4;
    const int K = g.K, nt = K / BK;
    unsigned voffA[2], voffB[2];
#pragma unroll
    for (int i = 0; i < 2; ++i) { int R, C; stage_rc(tid * 16 + i * 8192, R, C); const int Rb = Epi::PERM ? ((R & ~31) + perm32(R & 31)) : R;
        voffA[i] = (unsigned)(R * K + C) * 2u; voffB[i] = (unsigned)(Rb * K + C) * 2u; }
    const size_t kstep = (size_t)(BK * 2);
    const size_t hstep = (size_t)HALF * K * 2;
    const size_t tstep = 2 * hstep;
    const unsigned ldsw = (unsigned)wid * 1024u;
    const int aoff = lds_byte(wr * 64 + fr, fq * 8), boff = lds_byte(wc * 32 + fr, fq * 8);
#define PG8_SA(b, h) (((b) * 2 + (h)) * HTB)
#define PG8_SB(b, h) ((4 + (b) * 2 + (h)) * HTB)
#define PG8_STAGE(bufoff, gbase, voff) do { _Pragma("unroll") for (int _i = 0; _i < 2; ++_i) \
        __builtin_amdgcn_global_load_lds((const unsigned*)((const char*)(gbase) + (voff)[_i]), (PG8_LAS unsigned*)(lds + (bufoff) + ldsw + _i * 8192), 16, 0, 0); } while (0)
#define PG8_LDA(dst, b, h) do { _Pragma("unroll") for (int m = 0; m < 4; ++m) _Pragma("unroll") for (int k = 0; k < 2; ++k) dst[m][k] = *(const PG8_LAS bf16x8*)(lds + PG8_SA(b, h) + aoff + m * 2048 + k * 1024); } while (0)
#define PG8_LDB(dst, b, h) do { _Pragma("unroll") for (int n = 0; n < 2; ++n) _Pragma("unroll") for (int k = 0; k < 2; ++k) dst[n][k] = *(const PG8_LAS bf16x8*)(lds + PG8_SB(b, h) + boff + n * 2048 + k * 1024); } while (0)
#define PG8_MMA(ai, bj, At, Bt) do { __builtin_amdgcn_s_setprio(1); _Pragma("unroll") for (int m = 0; m < 4; ++m) _Pragma("unroll") for (int n = 0; n < 2; ++n) _Pragma("unroll") for (int k = 0; k < 2; ++k) \
        acc[ai][bj][m][n] = __builtin_amdgcn_mfma_f32_16x16x32_bf16(Bt[n][k], At[m][k], acc[ai][bj][m][n], 0, 0, 0); __builtin_amdgcn_s_setprio(0); } while (0)
#define PG8_WAIT_V(n) asm volatile("s_waitcnt vmcnt(" #n ")" ::: "memory")
#define PG8_WAIT_L(n) asm volatile("s_waitcnt lgkmcnt(" #n ")" ::: "memory")
#define PG8_BAR __builtin_amdgcn_s_barrier()
#define PG8_SCHED __builtin_amdgcn_sched_barrier(0)
    Unit cur, nxt; int ui = 0;
    if (!S.next(0, cur)) return;
    f32x4 acc[2][2][4][2];
#pragma unroll
    for (int a = 0; a < 2; ++a)
#pragma unroll
        for (int b = 0; b < 2; ++b)
#pragma unroll
            for (int m = 0; m < 4; ++m)
#pragma unroll
                for (int n = 0; n < 2; ++n) acc[a][b][m][n] = (f32x4){0.f, 0.f, 0.f, 0.f};
    bf16x8 At[4][2], B0[2][2], B1[2][2];
    const char* cA = (const char*)g.A + (size_t)cur.pm * tstep; const char* cB = (const char*)g.Bt + (size_t)cur.pn * tstep;
    S.a_ready(cur);
    if constexpr (SP2) {
        PG8_STAGE(PG8_SB(0, 0), cB, voffB); PG8_STAGE(PG8_SB(0, 1), cB + hstep, voffB); PG8_STAGE(PG8_SA(0, 0), cA, voffA); PG8_STAGE(PG8_SA(0, 1), cA + hstep, voffA);
        if (wr == 1) PG8_BAR;
        PG8_WAIT_V(2); PG8_BAR;
        PG8_STAGE(PG8_SB(1, 0), cB + kstep, voffB); PG8_STAGE(PG8_SA(1, 0), cA + kstep, voffA); PG8_STAGE(PG8_SB(1, 1), cB + hstep + kstep, voffB);
        PG8_WAIT_V(6); PG8_BAR;
    } else {
        PG8_STAGE(PG8_SB(0, 0), cB, voffB); PG8_STAGE(PG8_SA(0, 0), cA, voffA); PG8_STAGE(PG8_SB(0, 1), cB + hstep, voffB); PG8_STAGE(PG8_SA(0, 1), cA + hstep, voffA);
        if (wr == 1) PG8_BAR;
        PG8_WAIT_V(4); PG8_BAR;
        PG8_STAGE(PG8_SB(1, 0), cB + kstep, voffB); PG8_STAGE(PG8_SA(1, 0), cA + kstep, voffA); PG8_STAGE(PG8_SB(1, 1), cB + hstep + kstep, voffB);
        PG8_WAIT_V(6); PG8_BAR;
    }
    for (;;) {
        const bool has_next = S.next(ui + 1, nxt);
        const char* nA = has_next ? (const char*)g.A + (size_t)nxt.pm * tstep : cA; const char* nB = has_next ? (const char*)g.Bt + (size_t)nxt.pn * tstep : cB;
        for (int t = 0; t < nt; t += 2) {
            if constexpr (Epi::MID) { if (t == (nt >> 1)) E.mid(acc, cur, wr, wc, fr, fq); }
            const bool last = (t == nt - 2);
            const char* a1 = cA + (size_t)(t + 1) * kstep;
            const char* a2 = last ? nA : cA + (size_t)(t + 2) * kstep; const char* b2 = last ? nB : cB + (size_t)(t + 2) * kstep;
            const char* a3 = a2 + kstep; const char* b3 = b2 + kstep;
            if (last && has_next) S.a_ready(nxt);
            if constexpr (SP2) {
            PG8_LDB(B0, 0, 0); PG8_LDB(B1, 0, 1); PG8_SCHED; PG8_LDA(At, 0, 0); PG8_STAGE(PG8_SA(1, 1), a1 + hstep, voffA);
            PG8_WAIT_V(8); PG8_WAIT_L(0); PG8_BAR; PG8_MMA(0, 0, At, B0); PG8_MMA(0, 1, At, B1); PG8_BAR; PG8_SCHED;
            PG8_LDA(At, 0, 1); PG8_STAGE(PG8_SB(0, 0), b2, voffB); PG8_STAGE(PG8_SB(0, 1), b2 + hstep, voffB); PG8_STAGE(PG8_SA(0, 0), a2, voffA);
            PG8_WAIT_V(8); PG8_WAIT_L(0); PG8_BAR; PG8_MMA(1, 0, At, B0); PG8_MMA(1, 1, At, B1); PG8_BAR; PG8_SCHED;
            PG8_LDB(B0, 1, 0); PG8_LDB(B1, 1, 1); PG8_SCHED; PG8_LDA(At, 1, 0); PG8_STAGE(PG8_SA(0, 1), a2 + hstep, voffA);
            PG8_WAIT_V(8); PG8_WAIT_L(0); PG8_BAR; PG8_MMA(0, 0, At, B0); PG8_MMA(0, 1, At, B1); PG8_BAR; PG8_SCHED;
            PG8_LDA(At, 1, 1); PG8_STAGE(PG8_SB(1, 0), b3, voffB); PG8_STAGE(PG8_SB(1, 1), b3 + hstep, voffB); PG8_STAGE(PG8_SA(1, 0), a3, voffA);
            PG8_WAIT_V(8); PG8_WAIT_L(0); PG8_BAR; PG8_MMA(1, 0, At, B0); PG8_MMA(1, 1, At, B1); PG8_BAR; PG8_SCHED;
            } else {
            PG8_LDB(B0, 0, 0); PG8_SCHED; PG8_LDA(At, 0, 0); PG8_STAGE(PG8_SA(1, 1), a1 + hstep, voffA);
            PG8_WAIT_L(8); PG8_BAR; PG8_WAIT_L(0); PG8_MMA(0, 0, At, B0); PG8_BAR; PG8_SCHED;
            PG8_LDB(B1, 0, 1); PG8_STAGE(PG8_SB(0, 0), b2, voffB);
            PG8_BAR; PG8_WAIT_L(0); PG8_MMA(0, 1, At, B1); PG8_BAR;
            PG8_LDA(At, 0, 1); PG8_STAGE(PG8_SA(0, 0), a2, voffA);
            PG8_BAR; PG8_WAIT_L(0); PG8_MMA(1, 0, At, B0); PG8_BAR; PG8_SCHED;
            PG8_STAGE(PG8_SB(0, 1), b2 + hstep, voffB);
            PG8_WAIT_V(6); PG8_BAR; PG8_MMA(1, 1, At, B1); PG8_BAR;
            PG8_LDB(B0, 1, 0); PG8_SCHED; PG8_LDA(At, 1, 0); PG8_STAGE(PG8_SA(0, 1), a2 + hstep, voffA);
            PG8_WAIT_L(8); PG8_BAR; PG8_WAIT_L(0); PG8_MMA(0, 0, At, B0); PG8_BAR; PG8_SCHED;
            PG8_LDB(B1, 1, 1); PG8_STAGE(PG8_SB(1, 0), b3, voffB);
            PG8_BAR; PG8_WAIT_L(0); PG8_MMA(0, 1, At, B1); PG8_BAR;
            PG8_LDA(At, 1, 1); PG8_STAGE(PG8_SA(1, 0), a3, voffA);
            PG8_BAR; PG8_WAIT_L(0); PG8_MMA(1, 0, At, B0); PG8_BAR; PG8_SCHED;
            PG8_STAGE(PG8_SB(1, 1), b3 + hstep, voffB);
            PG8_WAIT_V(6); PG8_BAR; PG8_MMA(1, 1, At, B1); PG8_BAR;
            }
        }
        if constexpr (ALIGN_EPI) { if (wr == 0) PG8_BAR; }
        if constexpr (!Epi::AFTER_DRAIN) { E(acc, cur, wr, wc, fr, fq); S.done(cur); }
        if (!has_next) break;
#pragma unroll
        for (int a = 0; a < 2; ++a)
#pragma unroll
            for (int b = 0; b < 2; ++b)
#pragma unroll
                for (int m = 0; m < 4; ++m)
#pragma unroll
                    for (int n = 0; n < 2; ++n) acc[a][b][m][n] = (f32x4){0.f, 0.f, 0.f, 0.f};
        cur = nxt; cA = nA; cB = nB; ++ui;
        if constexpr (ALIGN_EPI) { if (wr == 1) PG8_BAR; }
    }
    PG8_WAIT_V(0);
    if constexpr (!ALIGN_EPI) { if (wr == 0) PG8_BAR; }
    PG8_BAR;
    if constexpr (Epi::AFTER_DRAIN) { E.fused(acc, cur, wr, wc, fr, fq, lds, wid, lane); S.done(cur); }
#undef PG8_SA
#undef PG8_SB
#undef PG8_STAGE
#undef PG8_LDA
#undef PG8_LDB
#undef PG8_MMA
#undef PG8_WAIT_V
#undef PG8_WAIT_L
#undef PG8_BAR
#undef PG8_SCHED
}
}

constexpr int NWAVES = 8;
#ifndef MK_N_LAUNCHES
#define MK_N_LAUNCHES 1
#endif
constexpr int PER_PHASE = 8;
constexpr int N_LAUNCHES = MK_N_LAUNCHES;

constexpr int BATCH = 16, SEQ = 2048, D = 1024, M = BATCH * SEQ, NH = 8, DFF = 2816, INC = 7168;
constexpr float RMS_EPS = 1e-6f, LN_EPS = 1e-5f;

constexpr size_t MiB = 1u << 20;
constexpr size_t WS_CTL = 0, CTL_ZERO_BYTES = 1 * MiB;
constexpr size_t WS_WIN = 2 * MiB;
constexpr size_t WS_WCA = 16 * MiB;
constexpr size_t WS_WO = 20 * MiB;
constexpr size_t WS_WGU = 22 * MiB;
constexpr size_t WS_WD = 33 * MiB;
constexpr size_t WS_ROPE = 40 * MiB;
constexpr size_t WS_RS1 = 40 * MiB + 256 * 1024;
constexpr size_t WS_PART1 = 41 * MiB, WS_PART2 = 43 * MiB;
constexpr size_t WS_XB = 48 * MiB;
constexpr size_t WS_U = 112 * MiB;
constexpr size_t WS_CA = 176 * MiB;
constexpr size_t WS_V = 304 * MiB;
constexpr size_t WS_K = 368 * MiB;
constexpr size_t WS_MERGED = 432 * MiB;
constexpr size_t WS_END = 496 * MiB;
constexpr size_t WS_X1B = WS_U, WS_FF = WS_CA;
static_assert(WS_WD + (size_t)D * DFF * 2 <= WS_ROPE && WS_FF + (size_t)M * DFF * 2 <= WS_K && WS_PART2 + (size_t)M * 64 <= WS_XB, "d_ws map");
constexpr int CW_TMO = 0, CW_CODE = 1;
constexpr int CW_BAR = 4096;

constexpr int RING_OFF = 0, RING_BYTES = 131072;
constexpr int LDSCTL_OFF = RING_BYTES, MISC_OFF = LDSCTL_OFF + 320;
constexpr int LDS_BYTES = 147456;
static_assert(MISC_OFF + 128 <= LDS_BYTES, "LDS map");
#define GAS __attribute__((address_space(1)))
#define LAS __attribute__((address_space(3)))
typedef unsigned short bf16;
typedef unsigned v4u __attribute__((ext_vector_type(4)));
typedef float f32x4 __attribute__((ext_vector_type(4)));
typedef short bf16x8 __attribute__((ext_vector_type(8)));
typedef GAS unsigned gu32;
typedef GAS unsigned long long gu64;
#define RLX_AGENT __ATOMIC_RELAXED, __HIP_MEMORY_SCOPE_AGENT
#define LDS_WAIT() asm volatile("s_waitcnt lgkmcnt(0)" ::: "memory")
#define VM_WAIT() asm volatile("s_waitcnt vmcnt(0)" ::: "memory")
__device__ __forceinline__ unsigned long long rt() { return __builtin_amdgcn_s_memrealtime(); }
__device__ __forceinline__ unsigned f2bf(float f) { unsigned u = __builtin_bit_cast(unsigned, f); return (u + 0x7fffu + ((u >> 16) & 1u)) >> 16; }
__device__ __forceinline__ unsigned pk2(float lo, float hi) { return f2bf(lo) | (f2bf(hi) << 16); }

#define XB_TMO      128
#define XB_XCNT(j)  (256  + 64 * (j))
#define XB_XSUB(j)  (1280 + 64 * (j))
#define XB_XGEN(j)  (2304 + 64 * (j))
#define XB_TOP      3328
#define XB_TOPGEN   3392
#define XCD_BAR_WORDS 3456
#define XB_SPIN_CAP (1u << 18)

__device__ __forceinline__ unsigned xb_ld(unsigned* p)              { return __hip_atomic_load(p, __ATOMIC_RELAXED, __HIP_MEMORY_SCOPE_AGENT); }
__device__ __forceinline__ unsigned xb_add(unsigned* p, unsigned v) { return __hip_atomic_fetch_add(p, v, __ATOMIC_RELAXED, __HIP_MEMORY_SCOPE_AGENT); }
__device__ __forceinline__ unsigned xb_xcc_id() { return (unsigned)__builtin_amdgcn_s_getreg((3 << 11) | 20) & 0xFu; }
#define XB_SPIN(cond, bar) do { unsigned _sp = 0; while (cond) { __builtin_amdgcn_s_sleep(1); \
    if ((++_sp & 255u) == 0u) { if (xb_ld(&(bar)[XB_TMO])) break; if (_sp > XB_SPIN_CAP) { atomicAdd(&(bar)[XB_TMO], 1u); break; } } } } while (0)

struct XcdBarrier {
    unsigned* bar; unsigned x;
    volatile LAS unsigned* st;
};

__device__ __forceinline__ XcdBarrier xcd_barrier_post(unsigned* bar, volatile LAS unsigned* st) {
    XcdBarrier b; b.bar = bar; b.x = xb_xcc_id(); b.st = st;
    if (threadIdx.x == 0) (void)xb_add(&bar[XB_XCNT(b.x)], 1u);
    return b;
}
__device__ __forceinline__ void xcd_barrier_complete(unsigned* bar, unsigned x, unsigned& nloc, unsigned& nx) {
    const unsigned G = gridDim.x * gridDim.y * gridDim.z;
    unsigned sum, cnt, mine, sp = 0u;
    for (;;) {
        sum = 0u; cnt = 0u; mine = 0u;
#pragma unroll
        for (unsigned j = 0; j < 16; ++j) { const unsigned c = xb_ld(&bar[XB_XCNT(j)]); sum += c; cnt += (c > 0u) ? 1u : 0u; mine = (j == x) ? c : mine; }
        if (sum == G) break;
        __builtin_amdgcn_s_sleep(1);
        if ((++sp & 255u) == 0u) { if (xb_ld(&bar[XB_TMO])) break; if (sp > XB_SPIN_CAP) { atomicAdd(&bar[XB_TMO], 1u); break; } }
    }
    nloc = mine > 0u ? mine : 1u; nx = cnt > 0u ? cnt : 1u;
}

__device__ __forceinline__ void xcd_barrier(const XcdBarrier& b) {
    asm volatile("s_waitcnt vmcnt(0)" ::: "memory");
    __syncthreads();
    if (threadIdx.x == 0) {
        unsigned* bar = b.bar;
        __builtin_amdgcn_s_waitcnt(0);
        unsigned nloc = b.st[0], nx = b.st[1];
        if (nloc == 0u) { xcd_barrier_complete(bar, b.x, nloc, nx); b.st[0] = nloc; b.st[1] = nx; }
        const unsigned old = xb_add(&bar[XB_XSUB(b.x)], 1u);
        const unsigned gen = old / nloc;
        if (old + 1u == (gen + 1u) * nloc) {
            __builtin_amdgcn_fence(__ATOMIC_RELEASE, "agent");
            asm volatile("s_waitcnt vmcnt(0)" ::: "memory");
            const unsigned og = xb_add(&bar[XB_TOP], 1u);
            const unsigned tg = og / nx;
            if (og + 1u == (tg + 1u) * nx) xb_add(&bar[XB_TOPGEN], 1u);
            else XB_SPIN(xb_ld(&bar[XB_TOPGEN]) == tg, bar);
            __builtin_amdgcn_fence(__ATOMIC_ACQUIRE, "agent");
            xb_add(&bar[XB_XGEN(b.x)], 1u);
            asm volatile("s_waitcnt vmcnt(0)" ::: "memory");
        } else {
            XB_SPIN(xb_ld(&bar[XB_XGEN(b.x)]) == gen, bar);
            __builtin_amdgcn_fence(__ATOMIC_ACQUIRE, "agent");
            asm volatile("s_waitcnt vmcnt(0)" ::: "memory");
        }
    }
    __syncthreads();
}

struct Frame {
    LAS unsigned char* lds;
    volatile LAS unsigned* MISC;
    gu32* ctl;
    int tid, lane, wave;
    int vcu, G;
};

__device__ __forceinline__ float wave_sum(float v) {
#pragma unroll
    for (int o = 1; o < 64; o <<= 1) v += __shfl_xor(v, o);
    return v;
}

__device__ __forceinline__ int map_in(int n) {
    if (n < 1024) return ((n >> 7) << 8) + (n & 127);
    if (n < 2048) { const int c = n - 1024; return ((c >> 7) << 8) + 128 + (c & 127); }
    if (n < 4096) { const int d = n & 63; const int dp = d < 16 ? (2 * (d & 7) + (d >> 3)) : d; return n - d + dp; }
    if (n < 5120) return n;
    if (n < 6144) { const int c = n - 5120; return 5120 + ((c >> 7) << 8) + (c & 127); }
    { const int c = n - 6144; return 5120 + ((c >> 7) << 8) + 128 + (c & 127); }
}
template <int MAP> __device__ __forceinline__ int maprow(int n) {
    if (MAP == 1) return map_in(n);
    if (MAP == 2) return ((n >> 7) << 8) + (n & 127);
    if (MAP == 3) return ((n >> 7) << 8) + 128 + (n & 127);
    return n;
}
template <int MAP> __device__ __forceinline__ void p0_transpose_item(const float* W, int K, int N, bf16* WT, int ldt, int koff, const float* g, LAS float* scr, int item, int lane) {
    const int nblk = N / 32, kb = item / nblk, nb = item % nblk, k0 = 64 * kb, n0 = 32 * nb;
    float wv[32];
#pragma unroll
    for (int i = 0; i < 32; ++i) { const int kk = 2 * i + (lane >> 5); wv[i] = W[(size_t)(k0 + kk) * N + n0 + (lane & 31)]; }
    if (g) {
#pragma unroll
        for (int i = 0; i < 32; ++i) wv[i] *= g[k0 + 2 * i + (lane >> 5)]; }
#pragma unroll
    for (int i = 0; i < 32; ++i) { const int kk = 2 * i + (lane >> 5); scr[kk * 33 + (lane & 31)] = wv[i]; }
    LDS_WAIT(); asm volatile("" ::: "memory");
    const int c = lane & 7;
#pragma unroll
    for (int j = 0; j < 4; ++j) { const int n = (lane >> 3) + 8 * j; const LAS float* s = scr + (8 * c) * 33 + n;
        v4u o; o.x = pk2(s[0 * 33], s[1 * 33]); o.y = pk2(s[2 * 33], s[3 * 33]); o.z = pk2(s[4 * 33], s[5 * 33]); o.w = pk2(s[6 * 33], s[7 * 33]);
        *(GAS v4u*)(WT + (size_t)maprow<MAP>(n0 + n) * ldt + koff + k0 + 8 * c) = o; }
    LDS_WAIT(); asm volatile("" ::: "memory");
}
template <int NR> __device__ __forceinline__ void p0_rows(const float* xrow, bf16* orow, float* rs, int lane) {
    f32x4 v[NR][4]; float s[NR];
#pragma unroll
    for (int r = 0; r < NR; ++r)
#pragma unroll
        for (int j = 0; j < 4; ++j) v[r][j] = ((const GAS f32x4*)(xrow + (size_t)r * D) + lane)[64 * j];
#pragma unroll
    for (int r = 0; r < NR; ++r) { s[r] = 0.f;
#pragma unroll
        for (int j = 0; j < 4; ++j) s[r] += (v[r][j].x * v[r][j].x + v[r][j].y * v[r][j].y) + (v[r][j].z * v[r][j].z + v[r][j].w * v[r][j].w);
        s[r] = wave_sum(s[r]); }
#pragma unroll
    for (int r = 0; r < NR; ++r) { if (lane == 0) rs[r] = 1.f / sqrtf(s[r] * (1.f / D) + RMS_EPS);
        GAS unsigned long long* o8 = (GAS unsigned long long*)(orow + (size_t)r * D) + lane;
#pragma unroll
        for (int j = 0; j < 4; ++j) o8[64 * j] = (unsigned long long)pk2(v[r][j].x, v[r][j].y) | ((unsigned long long)pk2(v[r][j].z, v[r][j].w) << 32); }
}
__device__ __forceinline__ void rope_entry(int e, float* rope) {
    const int pos = e >> 3, i = e & 7;
    const float invf = i == 0 ? 1.0f : i == 1 ? 0.1939227432012558f : i == 2 ? 0.03760603070259094f : i == 3 ? 0.007292664609849453f : i == 4 ? 0.0014142135623842478f
                     : i == 5 ? 0.00027424818836152554f : i == 6 ? 5.3182957344688475e-05f : 1.0313385246263351e-05f;
    const float angf = (float)pos * invf; const double a = (double)angf;
    const double kq = __builtin_rint(a * 0.63661977236758134308);
    double r = __builtin_fma(-kq, 1.57079632679489655800, a); r = __builtin_fma(-kq, 6.12323399573676603587e-17, r);
    const double r2 = r * r;
    double sp = -7.6471637318198164759e-13; sp = sp * r2 + 1.6059043836821614599e-10; sp = sp * r2 - 2.5052108385441718775e-08; sp = sp * r2 + 2.7557319223985890653e-06;
    sp = sp * r2 - 1.9841269841269841270e-04; sp = sp * r2 + 8.3333333333333333333e-03; sp = sp * r2 - 1.6666666666666666667e-01; const double sn = r + r * r2 * sp;
    double cp = 4.7794773323873852974e-14; cp = cp * r2 - 1.1470745597729724714e-11; cp = cp * r2 + 2.0876756987868098979e-09; cp = cp * r2 - 2.7557319223985890653e-07;
    cp = cp * r2 + 2.4801587301587301587e-05; cp = cp * r2 - 1.3888888888888888889e-03; cp = cp * r2 + 4.1666666666666666667e-02; cp = cp * r2 - 0.5; const double cs = 1.0 + r2 * cp;
    const int q = (int)((long long)kq & 3);
    const double c = q == 0 ? cs : q == 1 ? -sn : q == 2 ? -cs : sn, s = q == 0 ? sn : q == 1 ? cs : q == 2 ? -sn : -cs;
    rope[2 * e] = (float)c; rope[2 * e + 1] = (float)s;
}
struct P0Args { const float *x, *g_mix, *w_in, *w_cpw, *w_apw, *w_out, *g_ffn, *w_fg, *w_fu, *w_fd; bf16 *WIN, *WCA, *WO, *WGU, *WD, *XB; float *rs1, *rope; };
__device__ __forceinline__ void p0_prologue(Frame& F, const P0Args& a) {
    LAS float* scr = (LAS float*)(F.lds + RING_OFF + F.wave * 16384);
    const int gw = F.vcu * NWAVES + F.wave, NGW = F.G * NWAVES;
    constexpr int I_IN = (D / 64) * (INC / 32), I_SQ = (D / 64) * (D / 32), I_GU = (D / 64) * (DFF / 32), I_DN = (DFF / 64) * (D / 32);
    constexpr int NITEMS = I_IN + 3 * I_SQ + 2 * I_GU + I_DN;
    for (int it = gw; it < NITEMS; it += NGW) {
        int r = it;
        if (r < I_IN) { p0_transpose_item<1>(a.w_in, D, INC, a.WIN, D, 0, a.g_mix, scr, r, F.lane); continue; } r -= I_IN;
        if (r < I_SQ) { p0_transpose_item<0>(a.w_cpw, D, D, a.WCA, 2 * D, 0, nullptr, scr, r, F.lane); continue; } r -= I_SQ;
        if (r < I_SQ) { p0_transpose_item<0>(a.w_apw, D, D, a.WCA, 2 * D, D, nullptr, scr, r, F.lane); continue; } r -= I_SQ;
        if (r < I_SQ) { p0_transpose_item<0>(a.w_out, D, D, a.WO, D, 0, nullptr, scr, r, F.lane); continue; } r -= I_SQ;
        if (r < I_GU) { p0_transpose_item<2>(a.w_fg, D, DFF, a.WGU, D, 0, a.g_ffn, scr, r, F.lane); continue; } r -= I_GU;
        if (r < I_GU) { p0_transpose_item<3>(a.w_fu, D, DFF, a.WGU, D, 0, a.g_ffn, scr, r, F.lane); continue; } r -= I_GU;
        p0_transpose_item<0>(a.w_fd, DFF, D, a.WD, DFF, 0, nullptr, scr, r, F.lane);
    }
    for (int m = gw * 4; m < M; m += NGW * 4) p0_rows<4>(a.x + (size_t)m * D, a.XB + (size_t)m * D, a.rs1 + m, F.lane);
    for (int e = (F.vcu * NWAVES + F.wave) * 64 + F.lane; e < SEQ * 8; e += F.G * NWAVES * 64) rope_entry(e, a.rope);
}

#ifdef PROBE_A
#define CSTAMP(k) do { if (F.tid == 0) F.MISC[12 + (k)] = (unsigned)rt(); } while (0)
#else
#define CSTAMP(k) do { } while (0)
#endif
struct ConvArgs { const bf16* U; bf16* CA; const float *wdw, *bdw, *gln, *bln; };
typedef float f32x2 __attribute__((ext_vector_type(2)));
__device__ __forceinline__ void fmac_(float& a, float w, float u) { asm("v_fmac_f32_e32 %0, %1, %2" : "+v"(a) : "v"(w), "v"(u)); }
template <int I> struct ConvLoop {
    static __device__ __forceinline__ void run(float (&a0)[32], float (&a1)[32], const float (&w0)[31], const float (&w1)[31], const LAS unsigned char* up) {
        const unsigned uv = *(const LAS unsigned*)(up + I * 2048);
        const float u0 = __uint_as_float(uv << 16), u1 = __uint_as_float(uv & 0xffff0000u);
        constexpr int OLO = I > 30 ? I - 30 : 0, OHI = I < 31 ? I : 31;
#pragma unroll
        for (int o = OLO; o <= OHI; ++o) { fmac_(a0[o], w0[I - o], u0); fmac_(a1[o], w1[I - o], u1); }
        if ((I & 3) == 3) __builtin_amdgcn_sched_barrier(0);
        ConvLoop<I + 1>::run(a0, a1, w0, w1, up);
    }
};
template <> struct ConvLoop<62> { static __device__ __forceinline__ void run(float (&)[32], float (&)[32], const float (&)[31], const float (&)[31], const LAS unsigned char*) {} };
constexpr int CONV_TILE_BYTES = 62 * 2048, CONV_RED_OFF = CONV_TILE_BYTES, CONV_STAT_OFF = CONV_RED_OFF + 2048;
static_assert(CONV_STAT_OFF + 256 <= RING_BYTES, "conv LDS map");
__device__ __forceinline__ void conv_dma(Frame& F, const ConvArgs& a, int item) {
    const int row0 = item * 32; const bool head = ((row0 & (SEQ - 1)) == 0);
    const unsigned char* gsrc = (const unsigned char*)(a.U + ((size_t)row0 - 30) * D) + F.lane * 16;
    for (int p = head ? 60 + ((F.wave + 4) & 7) : F.wave; p < 124; p += 8)
        __builtin_amdgcn_global_load_lds((const unsigned*)(gsrc + (size_t)p * 1024), (LAS unsigned*)(F.lds + RING_OFF + p * 1024), 16, 0, 0);
    if (head) for (int q = F.tid; q < 60 * 64; q += NWAVES * 64) *(LAS v4u*)(F.lds + RING_OFF + q * 16) = (v4u){0u, 0u, 0u, 0u};
}
#define CONV_BAR() asm volatile("s_waitcnt lgkmcnt(0)\n\ts_barrier" ::: "memory")
__device__ __forceinline__ void conv_item(Frame& F, const ConvArgs& a, int item, int next_item, const float (&w0)[31], const float (&w1)[31]) {
    const int tid = F.tid, lane = F.lane, c0 = 2 * tid, row0 = item * 32;
    CSTAMP(30);
    float a0[32], a1[32];
#pragma unroll
    for (int o = 0; o < 32; ++o) { a0[o] = 0.f; a1[o] = 0.f; }
    asm volatile("s_waitcnt vmcnt(0) lgkmcnt(0)\n\ts_barrier" ::: "memory");
    CSTAMP(31);
    ConvLoop<0>::run(a0, a1, w0, w1, F.lds + RING_OFF + tid * 4);
    CSTAMP(32);
    const f32x2 bd = *(const f32x2*)(a.bdw + c0);
    LAS float* red = (LAS float*)(F.lds + RING_OFF + CONV_RED_OFF);
    LAS float* stat = (LAS float*)(F.lds + RING_OFF + CONV_STAT_OFF);
#define TR_STEP(OFF, N) { const bool up_ = (lane & (OFF)) != 0; _Pragma("unroll") for (int k = 0; k < (N); ++k) { const float send = up_ ? v[k] : v[k + (N)], keep = up_ ? v[k + (N)] : v[k]; v[k] = keep + __shfl_xor(send, (OFF)); } }
#pragma unroll
    for (int pass = 0; pass < 2; ++pass) {
        float v[32];
#pragma unroll
        for (int o = 0; o < 32; ++o) { if (pass == 0) { a0[o] += bd.x; a1[o] += bd.y; v[o] = a0[o] + a1[o]; } else v[o] = a0[o] * a0[o] + a1[o] * a1[o]; }
        TR_STEP(32, 16) TR_STEP(16, 8) TR_STEP(8, 4) TR_STEP(4, 2) TR_STEP(2, 1)
        v[0] += __shfl_xor(v[0], 1);
        if ((lane & 1) == 0) red[F.wave * 64 + pass * 32 + (lane >> 1)] = v[0];
    }
#undef TR_STEP
    CONV_BAR();
    if (next_item >= 0) conv_dma(F, a, next_item);
    if (tid < 32) { float s = 0.f, q = 0.f;
#pragma unroll
        for (int wv = 0; wv < 8; ++wv) { s += red[wv * 64 + tid]; q += red[wv * 64 + 32 + tid]; }
        const float mean = s * (1.f / D), var = q * (1.f / D) - mean * mean;
        stat[tid] = mean; stat[32 + tid] = 1.f / sqrtf(fmaxf(var, 0.f) + LN_EPS); }
    CONV_BAR();
    CSTAMP(33);
    const f32x2 gl = *(const f32x2*)(a.gln + c0), bl = *(const f32x2*)(a.bln + c0);
    bf16* op = a.CA + (size_t)row0 * 2048 + c0;
#pragma unroll
    for (int o = 0; o < 32; ++o) { const float mean = stat[o], rstd = stat[32 + o];
        const float y0 = (a0[o] - mean) * rstd * gl.x + bl.x, y1 = (a1[o] - mean) * rstd * gl.y + bl.y;
        *(unsigned*)op = pg8::cvt_pk_bf16(y0 * pg8::sigm(y0), y1 * pg8::sigm(y1));
        op += 2048; asm volatile("" : "+v"(op)); }
    CONV_BAR();
    CSTAMP(34);
}
#undef CONV_BAR

namespace att {
typedef short bf16x8 __attribute__((ext_vector_type(8)));
typedef short s16x4 __attribute__((ext_vector_type(4)));
typedef float f32x16 __attribute__((ext_vector_type(16)));
typedef short v4i16_t __attribute__((ext_vector_type(4)));
__device__ __forceinline__ int crow(int r, int hi) { return (r & 3) + 8 * (r >> 2) + 4 * hi; }
__device__ __forceinline__ s16x4 vtr(const LAS unsigned char* p) { return __builtin_bit_cast(s16x4, __builtin_amdgcn_ds_read_tr16_b64_v4i16((LAS v4i16_t*)p)); }
#define ATT_MFMA(a, b, c) __builtin_amdgcn_mfma_f32_32x32x16_bf16(a, b, c, 0, 0, 0)
__device__ __forceinline__ void attn_unit(int b, int h, int qb, bf16* CA, const bf16* Kp, const bf16* Vp, const float* gsub, float lam, LAS unsigned char* lds) {
    const int tid = threadIdx.x, lane = tid & 63, r32 = lane & 31, hi = lane >> 5;
    const int wid = __builtin_amdgcn_readfirstlane(tid >> 6), comp = wid >> 2, w4 = wid & 3;
    const int q0 = qb * 128, NT = 2 * qb + 2;
    const size_t rowbase = (size_t)b * SEQ;
    LAS float* wsf = (LAS float*)(lds + 65536) + wid * 32;
    const bf16* Qp = CA + (rowbase + q0 + w4 * 32 + r32) * 2048 + 1024 + h * 128 + comp * 64 + hi * 8;
    bf16x8 qr[4];
#pragma unroll
    for (int d0 = 0; d0 < 4; ++d0) qr[d0] = *(const bf16x8*)(Qp + d0 * 16);
    const unsigned char* Kt = (const unsigned char*)(Kp + (size_t)((b * 8 + h) * 32) * 8192) + tid * 16;
    const unsigned char* Vt = (const unsigned char*)(Vp + (size_t)((b * 8 + h) * 32) * 8192) + tid * 16;
    v4u ks0 = *(const v4u*)(Kt), ks1 = *(const v4u*)(Kt + 8192), vs0 = *(const v4u*)(Vt), vs1 = *(const v4u*)(Vt + 8192);
    { LAS unsigned char* d = lds + tid * 16; *(LAS v4u*)(d) = ks0; *(LAS v4u*)(d + 8192) = ks1; *(LAS v4u*)(d + 16384) = vs0; *(LAS v4u*)(d + 24576) = vs1; }
    __syncthreads();
    f32x16 o[4];
#pragma unroll
    for (int d = 0; d < 4; ++d)
#pragma unroll
        for (int r = 0; r < 16; ++r) o[d][r] = 0.f;
    float mref = -1e30f, l = 0.f;
    const int qrel = w4 * 32 + r32;
    for (int t = 0; t < NT; ++t) {
        const int buf = t & 1; const bool more = (t + 1 < NT);
        if (more) { const size_t go = (size_t)(t + 1) * 16384; ks0 = *(const v4u*)(Kt + go); ks1 = *(const v4u*)(Kt + go + 8192); vs0 = *(const v4u*)(Vt + go); vs1 = *(const v4u*)(Vt + go + 8192); }
        const int jb = t - (NT - 2);
        const bool skip = (jb == 1) && (w4 < 2);
        if (!skip) {
            const LAS unsigned char* kb = lds + buf * 32768 + comp * 8192 + hi * 1024 + r32 * 16;
            f32x16 p0, p1;
#pragma unroll
            for (int r = 0; r < 16; ++r) { p0[r] = 0.f; p1[r] = 0.f; }
#pragma unroll
            for (int d0 = 0; d0 < 4; ++d0) { const bf16x8 a0 = *(const LAS bf16x8*)(kb + d0 * 2048), a1 = *(const LAS bf16x8*)(kb + d0 * 2048 + 512);
                p0 = ATT_MFMA(a0, qr[d0], p0); p1 = ATT_MFMA(a1, qr[d0], p1); }
            if (jb >= 0) { const int kb_ = 64 * jb + 4 * hi;
#pragma unroll
                for (int r = 0; r < 16; ++r) { const int kv = kb_ + (r & 3) + 8 * (r >> 2); if (kv > qrel) p0[r] = -INFINITY; if (kv + 32 > qrel) p1[r] = -INFINITY; } }
            float rm = fmaxf(p0[0], p1[0]);
#pragma unroll
            for (int r = 1; r < 16; ++r) rm = fmaxf(rm, fmaxf(p0[r], p1[r]));
            rm = fmaxf(rm, __shfl_xor(rm, 32));
            if (__any(rm > mref + 8.f)) {
                const float mnew = fmaxf(mref, rm), f = pg8::ex2(mref - mnew); mref = mnew; l *= f;
                if (hi == 0) wsf[r32] = f;
#pragma unroll
                for (int r = 0; r < 16; ++r) { const float fr_ = wsf[crow(r, hi)];
#pragma unroll
                    for (int d = 0; d < 4; ++d) o[d][r] *= fr_; }
            }
            float sacc = 0.f;
#pragma unroll
            for (int r = 0; r < 16; ++r) { p0[r] = pg8::ex2(p0[r] - mref); p1[r] = pg8::ex2(p1[r] - mref); sacc += p0[r] + p1[r]; }
            l += sacc;
            v4u pw[4];
#pragma unroll
            for (int k = 0; k < 2; ++k) {
                pw[k] = (v4u){pg8::cvt_pk_bf16(p0[8 * k], p0[8 * k + 1]), pg8::cvt_pk_bf16(p0[8 * k + 2], p0[8 * k + 3]), pg8::cvt_pk_bf16(p0[8 * k + 4], p0[8 * k + 5]), pg8::cvt_pk_bf16(p0[8 * k + 6], p0[8 * k + 7])};
                pw[2 + k] = (v4u){pg8::cvt_pk_bf16(p1[8 * k], p1[8 * k + 1]), pg8::cvt_pk_bf16(p1[8 * k + 2], p1[8 * k + 3]), pg8::cvt_pk_bf16(p1[8 * k + 4], p1[8 * k + 5]), pg8::cvt_pk_bf16(p1[8 * k + 6], p1[8 * k + 7])}; }
            const LAS unsigned char* vb = lds + buf * 32768 + 16384 + (4 * hi + ((lane & 15) >> 2)) * 64 + ((lane >> 4) & 1) * 32 + (lane & 3) * 8;
#pragma unroll
            for (int d = 0; d < 4; ++d)
#pragma unroll
                for (int k = 0; k < 4; ++k) { const s16x4 lo = vtr(vb + (d * 4 + k) * 1024), hh = vtr(vb + (d * 4 + k) * 1024 + 512);
                    const bf16x8 vf = {lo[0], lo[1], lo[2], lo[3], hh[0], hh[1], hh[2], hh[3]};
                    o[d] = ATT_MFMA(__builtin_bit_cast(bf16x8, pw[k]), vf, o[d]); }
        }
        if (more) { LAS unsigned char* d = lds + (buf ^ 1) * 32768 + tid * 16; *(LAS v4u*)(d) = ks0; *(LAS v4u*)(d + 8192) = ks1; *(LAS v4u*)(d + 16384) = vs0; *(LAS v4u*)(d + 24576) = vs1; }
        __syncthreads();
    }
    l += __shfl_xor(l, 32);
    { float inv = 1.f / l; if (comp == 1) inv *= lam; if (hi == 0) wsf[r32] = inv; }
#pragma unroll
    for (int r = 0; r < 16; ++r) { const float ri = wsf[crow(r, hi)];
#pragma unroll
        for (int d = 0; d < 4; ++d) o[d][r] *= ri; }
    LAS f32x4* X = (LAS f32x4*)lds;
    if (comp == 1) {
#pragma unroll
        for (int d = 0; d < 4; ++d)
#pragma unroll
            for (int rq = 0; rq < 4; ++rq) X[((w4 * 4 + d) * 4 + rq) * 64 + lane] = (f32x4){o[d][4 * rq], o[d][4 * rq + 1], o[d][4 * rq + 2], o[d][4 * rq + 3]};
    }
    __syncthreads();
    if (comp == 0) {
        float ss[16];
#pragma unroll
        for (int r = 0; r < 16; ++r) ss[r] = 0.f;
#pragma unroll
        for (int d = 0; d < 4; ++d)
#pragma unroll
            for (int rq = 0; rq < 4; ++rq) { const f32x4 x = X[((w4 * 4 + d) * 4 + rq) * 64 + lane];
#pragma unroll
                for (int e = 0; e < 4; ++e) { const float y = o[d][4 * rq + e] - x[e]; o[d][4 * rq + e] = y; ss[4 * rq + e] += y * y; } }
#pragma unroll
        for (int r = 0; r < 16; ++r) {
#pragma unroll
            for (int off = 1; off < 32; off <<= 1) ss[r] += __shfl_xor(ss[r], off);
            ss[r] = 1.f / sqrtf(ss[r] * (1.f / 128.f) + RMS_EPS); }
        float gs[4];
#pragma unroll
        for (int d = 0; d < 4; ++d) gs[d] = gsub[32 * d + r32] * 0.8f;
        bf16* Op = CA + (rowbase + q0 + w4 * 32) * 2048 + 1024 + h * 128 + r32;
#pragma unroll
        for (int r = 0; r < 16; ++r) { bf16* rp = Op + (size_t)crow(r, hi) * 2048;
#pragma unroll
            for (int d = 0; d < 4; ++d) rp[32 * d] = (bf16)f2bf(o[d][r] * ss[r] * gs[d]); }
    }
    __syncthreads();
}
#undef ATT_MFMA
}

namespace att2 {
typedef short bf16x8 __attribute__((ext_vector_type(8)));
typedef short s16x4 __attribute__((ext_vector_type(4)));
typedef float f32x16 __attribute__((ext_vector_type(16)));
typedef short v4i16_t __attribute__((ext_vector_type(4)));
typedef __attribute__((address_space(3))) const char* lds_cptr;
constexpr int NW = 8, QBLK = 32, QB = 256, KVBLK = 64;
constexpr int KSLOT = 8192, VSLOT = 16384, NSLOT = 3;
constexpr int LDS_K = 0, LDS_V = NSLOT * KSLOT, LDS_WS = LDS_V + NSLOT * VSLOT, LDS_END = LDS_WS + NW * 64 * 4;
__device__ __forceinline__ int crow(int r, int hi) { return (r & 3) + 8 * (r >> 2) + 4 * hi; }
#define SBAR() __builtin_amdgcn_sched_barrier(0)
#define PIN(x) asm volatile("" : "+v"(x))
#define MFMA(a, b, c) __builtin_amdgcn_mfma_f32_32x32x16_bf16(a, b, c, 0, 0, 0)
#define WAIT_BAR(N) asm volatile("s_waitcnt vmcnt(" #N ") lgkmcnt(0)\n\ts_barrier" ::: "memory")
#define MX3(a, b, c) __builtin_fmaxf(__builtin_fmaxf((a), (b)), (c))
__device__ __forceinline__ void glds16(const void* g, unsigned lds_base) {
    unsigned sv; asm volatile("s_mov_b32 %0, m0\n\ts_mov_b32 m0, %2\n\ts_nop 0\n\tglobal_load_lds_dwordx4 %1, off\n\ts_mov_b32 m0, %0" : "=&s"(sv) : "v"(g), "s"(lds_base) : "memory"); }
__device__ __forceinline__ void kload2(bf16x8* kf, lds_cptr kp, int d0) { kf[2 * d0] = *(const __attribute__((address_space(3))) bf16x8*)(kp + d0 * 2048); kf[2 * d0 + 1] = *(const __attribute__((address_space(3))) bf16x8*)(kp + d0 * 2048 + 512); }
__device__ __forceinline__ s16x4 vtr(lds_cptr p) { return __builtin_bit_cast(s16x4, __builtin_amdgcn_ds_read_tr16_b64_v4i16((__attribute__((address_space(3))) v4i16_t*)p)); }
__device__ __forceinline__ unsigned cvtpk(float lo, float hi) { typedef float f2 __attribute__((ext_vector_type(2))); typedef __bf16 b2 __attribute__((ext_vector_type(2))); f2 v = {lo, hi}; b2 b = __builtin_convertvector(v, b2); return __builtin_bit_cast(unsigned, b); }
__device__ __forceinline__ float rowmax(const f32x16& p0, const f32x16& p1) {
    float a = MX3(p0[0], p0[1], p1[0]), b = MX3(p0[2], p0[3], p1[1]); a = MX3(a, p1[2], p1[3]);
#pragma unroll
    for (int r = 4; r < 16; r += 4) { a = MX3(a, p0[r], p0[r + 1]); b = MX3(b, p0[r + 2], p0[r + 3]); a = MX3(a, p1[r], p1[r + 1]); b = MX3(b, p1[r + 2], p1[r + 3]); }
    float m = __builtin_fmaxf(a, b); auto rr = __builtin_amdgcn_permlane32_swap(__float_as_uint(m), __float_as_uint(m), false, false);
    return __builtin_fmaxf(__uint_as_float(rr[0]), __uint_as_float(rr[1])); }
__device__ __forceinline__ void cmask(f32x16& p0, f32x16& p1, int jb, int qrel, int hi) {
    const int kb = 64 * jb + 4 * hi;
#pragma unroll
    for (int r = 0; r < 16; ++r) { const int kv = kb + (r & 3) + 8 * (r >> 2); if (kv > qrel) p0[r] = -INFINITY; if (kv + 32 > qrel) p1[r] = -INFINITY; } }

template <int THRL> __device__ __forceinline__ void attn_unit(int b, int h, int comp, int qb, bf16* CA, const bf16* __restrict__ Kp, const bf16* __restrict__ Vp, float* Osc, const float* gsub, float lam, char* shm) {
    int tid = threadIdx.x; asm volatile("" : "+v"(tid));
    const int lane = tid & 63, r32 = lane & 31, hi = lane >> 5; const int wid = __builtin_amdgcn_readfirstlane(tid >> 6);
    const long rowbase = (long)b * SEQ; const int q0 = qb * QB, NT = (q0 + QB) / KVBLK;
    const bf16* Qw = CA + (rowbase + q0 + wid * QBLK) * 2048 + 1024 + h * 128 + comp * 64;
    const unsigned lds0 = (unsigned)(uintptr_t)shm; float* wsf = (float*)(shm + LDS_WS) + wid * 64;
    const char* ksrc = (const char*)(Kp + (size_t)((b * 8 + h) * 32) * 8192) + comp * 8192 + wid * 1024 + lane * 16;
    const char* vsrc = (const char*)(Vp + (size_t)((b * 8 + h) * 32) * 8192) + wid * 1024 + lane * 16;
    const unsigned kdst = lds0 + LDS_K + wid * 1024, vdst = lds0 + LDS_V + wid * 1024;
#define DMA_K(t, slot) glds16(ksrc + (long)(t) * 16384, (unsigned)__builtin_amdgcn_readfirstlane(kdst + (slot)))
#define DMA_V(t, slot) do { glds16(vsrc + (long)(t) * 16384, (unsigned)__builtin_amdgcn_readfirstlane(vdst + 2 * (slot))); glds16(vsrc + (long)(t) * 16384 + 8192, (unsigned)__builtin_amdgcn_readfirstlane(vdst + 2 * (slot) + 8192)); } while (0)
    const lds_cptr vp0 = (lds_cptr)shm + LDS_V + ((lane >> 4) & 1) * 32 + (lane & 3) * 8 + (4 * hi + ((lane & 15) >> 2)) * 64;
    const lds_cptr kp0 = (lds_cptr)shm + LDS_K + hi * 1024 + r32 * 16;
    DMA_K(0, 0); DMA_V(0, 0); DMA_K(1, KSLOT);
    bf16x8 qr[4];
#pragma unroll
    for (int d0 = 0; d0 < 4; ++d0) qr[d0] = *reinterpret_cast<const bf16x8*>(&Qw[(long)r32 * 2048 + d0 * 16 + hi * 8]);
    float mhat = 0.f, l_reg = 0.f; f32x16 o[4];
#pragma unroll
    for (int d = 0; d < 4; ++d) o[d] = f32x16{};
    const int qrel = wid * QBLK + r32; bool resc = false;
    f32x16 c0, c1; bf16x8 kf[8]; s16x4 vlo[4], vhi[4]; v4u pwa[4], pwb[4]; const f32x16 zero16 = f32x16{};
    int sl_prev = 0, sl_cur = 0, sl_next = KSLOT;
#define ROT() do { sl_prev = sl_cur; sl_cur = sl_next; sl_next = (sl_next == 2 * KSLOT) ? 0 : sl_next + KSLOT; } while (0)
#define RESC() do { if (resc) { _Pragma("unroll") for (int r = 0; r < 16; ++r) { const float f_ = wsf[crow(r, hi)]; _Pragma("unroll") for (int d_ = 0; d_ < 4; ++d_) o[d_][r] *= f_; } } } while (0)
#define CMASK(t) do { const int jb_ = (t) - (NT - 4); if (jb_ >= 0) cmask(c0, c1, jb_, qrel, hi); } while (0)
#define VRD(i, f) do { vlo[i] = vtr(vp_ + (f) * 1024); vhi[i] = vtr(vp_ + (f) * 1024 + 512); } while (0)
#define VFR(i) (bf16x8){vlo[i][0], vlo[i][1], vlo[i][2], vlo[i][3], vhi[i][0], vhi[i][1], vhi[i][2], vhi[i][3]}
#define PAF(P, k) __builtin_bit_cast(bf16x8, P[k])
#define EX(v) __builtin_amdgcn_exp2f(v)
    DMA_K(2, 2 * KSLOT);
    WAIT_BAR(4);
#pragma unroll
    for (int d0 = 0; d0 < 4; ++d0) kload2(kf, kp0, d0);
    c0 = MFMA(kf[0], qr[0], zero16); c1 = MFMA(kf[1], qr[0], zero16); c0 = MFMA(kf[2], qr[1], c0); c1 = MFMA(kf[3], qr[1], c1);
    c0 = MFMA(kf[4], qr[2], c0); c1 = MFMA(kf[5], qr[2], c1); c0 = MFMA(kf[6], qr[3], c0); c1 = MFMA(kf[7], qr[3], c1);
    CMASK(0);
    { const float rm = rowmax(c0, c1); mhat = rm; float sacc = 0.f;
#pragma unroll
      for (int r = 0; r < 16; ++r) { c0[r] = EX(c0[r] - rm); c1[r] = EX(c1[r] - rm); sacc += c0[r] + c1[r]; }
      l_reg = sacc;
#pragma unroll
      for (int k = 0; k < 2; ++k) { pwa[k] = (v4u){cvtpk(c0[8 * k], c0[8 * k + 1]), cvtpk(c0[8 * k + 2], c0[8 * k + 3]), cvtpk(c0[8 * k + 4], c0[8 * k + 5]), cvtpk(c0[8 * k + 6], c0[8 * k + 7])};
                                    pwa[2 + k] = (v4u){cvtpk(c1[8 * k], c1[8 * k + 1]), cvtpk(c1[8 * k + 2], c1[8 * k + 3]), cvtpk(c1[8 * k + 4], c1[8 * k + 5]), cvtpk(c1[8 * k + 6], c1[8 * k + 7])}; } }
    WAIT_BAR(0);
    DMA_K(3, 0); DMA_V(1, KSLOT);
    ROT();
#pragma unroll
    for (int d0 = 0; d0 < 4; ++d0) kload2(kf, kp0 + sl_cur, d0);
    WAIT_BAR(3);
#define GA(MF) do { MF; SBAR(); } while (0)
#define GAV(i, f, MF) do { VRD(i, f); SBAR(); MF; SBAR(); } while (0)
#define GB(PC, w, j, C, B, MF) do { MF; C[B] = EX(C[B] - mhat); C[B + 1] = EX(C[B + 1] - mhat); sacc += C[B]; sacc += C[B + 1]; PC[w][j] = cvtpk(C[B], C[B + 1]); PIN(sacc); PIN(PC[w]); SBAR(); } while (0)
#define KRD(G, j) do { if (G) { kload2(kf, kp0 + sl_next, j); SBAR(); } } while (0)
#define STEP(PP, PC, t, GK, GV, GL) do { SBAR(); \
    const lds_cptr vp_ = vp0 + 2 * sl_prev; \
    GA(c0 = MFMA(kf[0], qr[0], zero16)); GA(c1 = MFMA(kf[1], qr[0], zero16)); GA(c0 = MFMA(kf[2], qr[1], c0)); GA(c1 = MFMA(kf[3], qr[1], c1)); \
    GAV(0, 0, c0 = MFMA(kf[4], qr[2], c0)); GAV(1, 1, c1 = MFMA(kf[5], qr[2], c1)); GAV(2, 2, c0 = MFMA(kf[6], qr[3], c0)); GAV(3, 3, c1 = MFMA(kf[7], qr[3], c1)); \
    if (GK) { DMA_K((t) + 3, sl_cur); } if (GV) { DMA_V((t) + 1, sl_next); } \
    CMASK(t); \
    { const float rm = rowmax(c0, c1); resc = false; \
      if (__builtin_expect(__any(rm - mhat > (float)THRL), 0)) { const float mn = __builtin_fmaxf(rm, mhat); \
        const float f = __builtin_amdgcn_exp2f(mhat - mn); mhat = mn; l_reg *= f; if (hi == 0) wsf[r32] = f; resc = true; } } \
    SBAR(); float sacc = 0.f; \
    GB(PC, 0, 0, c0, 0,  o[0] = MFMA(PAF(PP, 0), VFR(0), o[0])); VRD(0, 4);  SBAR(); \
    GB(PC, 0, 1, c0, 2,  o[0] = MFMA(PAF(PP, 1), VFR(1), o[0])); VRD(1, 5);  SBAR(); \
    GB(PC, 0, 2, c0, 4,  o[0] = MFMA(PAF(PP, 2), VFR(2), o[0])); VRD(2, 6);  SBAR(); \
    GB(PC, 0, 3, c0, 6,  o[0] = MFMA(PAF(PP, 3), VFR(3), o[0])); VRD(3, 7);  SBAR(); \
    GB(PC, 1, 0, c0, 8,  o[1] = MFMA(PAF(PP, 0), VFR(0), o[1])); VRD(0, 8);  SBAR(); \
    GB(PC, 1, 1, c0, 10, o[1] = MFMA(PAF(PP, 1), VFR(1), o[1])); VRD(1, 9);  SBAR(); \
    GB(PC, 1, 2, c0, 12, o[1] = MFMA(PAF(PP, 2), VFR(2), o[1])); VRD(2, 10); SBAR(); \
    GB(PC, 1, 3, c0, 14, o[1] = MFMA(PAF(PP, 3), VFR(3), o[1])); VRD(3, 11); SBAR(); \
    GB(PC, 2, 0, c1, 0,  o[2] = MFMA(PAF(PP, 0), VFR(0), o[2])); VRD(0, 12); SBAR(); \
    GB(PC, 2, 1, c1, 2,  o[2] = MFMA(PAF(PP, 1), VFR(1), o[2])); VRD(1, 13); SBAR(); \
    GB(PC, 2, 2, c1, 4,  o[2] = MFMA(PAF(PP, 2), VFR(2), o[2])); VRD(2, 14); SBAR(); \
    GB(PC, 2, 3, c1, 6,  o[2] = MFMA(PAF(PP, 3), VFR(3), o[2])); VRD(3, 15); SBAR(); \
    GB(PC, 3, 0, c1, 8,  o[3] = MFMA(PAF(PP, 0), VFR(0), o[3])); KRD(GL, 0); \
    GB(PC, 3, 1, c1, 10, o[3] = MFMA(PAF(PP, 1), VFR(1), o[3])); KRD(GL, 1); \
    GB(PC, 3, 2, c1, 12, o[3] = MFMA(PAF(PP, 2), VFR(2), o[3])); KRD(GL, 2); \
    GB(PC, 3, 3, c1, 14, o[3] = MFMA(PAF(PP, 3), VFR(3), o[3])); KRD(GL, 3); \
    l_reg += sacc; \
  } while (0)
    int t = 1;
#undef CMASK
#define CMASK(t) do { } while (0)
    for (; t + 5 < NT; t += 2) {
        STEP(pwa, pwb, t, true, true, true);     WAIT_BAR(3); RESC(); ROT();
        STEP(pwb, pwa, t + 1, true, true, true); WAIT_BAR(3); RESC(); ROT();
    }
#undef CMASK
#define CMASK(t) do { const int jb_ = (t) - (NT - 4); if (jb_ >= 0) cmask(c0, c1, jb_, qrel, hi); } while (0)
#define ENDW(tt) do { if ((tt) + 3 < NT) { WAIT_BAR(3); } else if ((tt) + 2 < NT) { WAIT_BAR(2); } else { WAIT_BAR(0); } } while (0)
    for (; t + 1 < NT; t += 2) {
        STEP(pwa, pwb, t, (t + 3 < NT), (t + 1 < NT), (t + 1 < NT));         ENDW(t);     RESC(); ROT();
        STEP(pwb, pwa, t + 1, (t + 4 < NT), (t + 2 < NT), (t + 2 < NT));     ENDW(t + 1); RESC(); ROT();
    }
    STEP(pwa, pwb, NT - 1, false, false, false); RESC();
    { const lds_cptr vp_ = vp0 + 2 * sl_cur; SBAR();
#pragma unroll
      for (int d = 0; d < 4; ++d) {
#pragma unroll
          for (int k = 0; k < 4; ++k) VRD(k, d * 4 + k);
#pragma unroll
          for (int k = 0; k < 4; ++k) o[d] = MFMA(PAF(pwb, k), VFR(k), o[d]); } }
    { auto rr = __builtin_amdgcn_permlane32_swap(__float_as_uint(l_reg), __float_as_uint(l_reg), false, false); l_reg = __uint_as_float(rr[0]) + __uint_as_float(rr[1]); }
    if (hi == 0) wsf[32 + r32] = l_reg;
    asm volatile("s_waitcnt lgkmcnt(0)" ::: "memory");
    const float osc = comp ? lam : 1.f;
    int lane_ = lane, wid_ = wid; asm volatile("" : "+v"(lane_), "+s"(wid_));
    const int r32_ = lane_ & 31, hi_ = lane_ >> 5;
#pragma unroll
    for (int r = 0; r < 16; ++r) { const float ri = __builtin_amdgcn_rcpf(wsf[32 + crow(r, hi)]) * osc;
#pragma unroll
        for (int d = 0; d < 4; ++d) o[d][r] *= ri; }
    f32x4* Ow = (f32x4*)Osc + (size_t)wid_ * 1024 + lane_;
    if (comp == 0) {
#pragma unroll
        for (int d = 0; d < 4; ++d)
#pragma unroll
            for (int rq = 0; rq < 4; ++rq) Ow[(d * 4 + rq) * 64] = (f32x4){o[d][4 * rq], o[d][4 * rq + 1], o[d][4 * rq + 2], o[d][4 * rq + 3]};
    } else {
        float ss[16];
#pragma unroll
        for (int r = 0; r < 16; ++r) ss[r] = 0.f;
#pragma unroll
        for (int d = 0; d < 4; ++d)
#pragma unroll
            for (int rq = 0; rq < 4; ++rq) { const f32x4 x = __builtin_nontemporal_load(Ow + (d * 4 + rq) * 64);
#pragma unroll
                for (int e = 0; e < 4; ++e) { const float y = x[e] - o[d][4 * rq + e]; o[d][4 * rq + e] = y; ss[4 * rq + e] += y * y; } }
#pragma unroll
        for (int r = 0; r < 16; ++r) {
#pragma unroll
            for (int off = 1; off < 32; off <<= 1) ss[r] += __shfl_xor(ss[r], off);
            ss[r] = 1.f / sqrtf(ss[r] * (1.f / 128.f) + RMS_EPS); }
        float gs[4];
#pragma unroll
        for (int d = 0; d < 4; ++d) gs[d] = gsub[32 * d + r32_] * 0.8f;
        bf16* Op = CA + (rowbase + q0 + wid_ * QBLK) * 2048 + 1024 + h * 128 + r32_;
#pragma unroll
        for (int r = 0; r < 16; ++r) { bf16* rp = Op + (size_t)crow(r, hi_) * 2048;
#pragma unroll
            for (int d = 0; d < 4; ++d) rp[32 * d] = (bf16)f2bf(o[d][r] * ss[r] * gs[d]); }
    }
    asm volatile("s_waitcnt vmcnt(0) lgkmcnt(0)\n\ts_barrier" ::: "memory");
#undef DMA_K
#undef DMA_V
#undef ROT
#undef RESC
#undef CMASK
#undef VRD
#undef VFR
#undef PAF
#undef EX
#undef GA
#undef GAV
#undef GB
#undef KRD
#undef STEP
#undef ENDW
}
#undef SBAR
#undef PIN
#undef MFMA
#undef WAIT_BAR
#undef MX3
}

__device__ __forceinline__ void final_rows(Frame& F, float* out, const float* part, const float* gfin) {
    const int gw = F.vcu * NWAVES + F.wave, NGW = F.G * NWAVES;
    f32x4 g[4];
#pragma unroll
    for (int j = 0; j < 4; ++j) g[j] = *((const GAS f32x4*)gfin + F.lane + 64 * j);
    for (int m = gw; m < M; m += NGW) {
        GAS f32x4* xr = (GAS f32x4*)(out + (size_t)m * D) + F.lane;
        f32x4 v[4];
#pragma unroll
        for (int j = 0; j < 4; ++j) v[j] = xr[64 * j];
        const f32x4 p0 = *(const f32x4*)(part + (size_t)m * 16), p1 = *(const f32x4*)(part + (size_t)m * 16 + 4), p2 = *(const f32x4*)(part + (size_t)m * 16 + 8), p3 = *(const f32x4*)(part + (size_t)m * 16 + 12);
        const float s = (((p0[0] + p0[1]) + (p0[2] + p0[3])) + ((p1[0] + p1[1]) + (p1[2] + p1[3]))) + (((p2[0] + p2[1]) + (p2[2] + p2[3])) + ((p3[0] + p3[1]) + (p3[2] + p3[3])));
        const float rs = 1.f / sqrtf(s * (1.f / D) + RMS_EPS);
#pragma unroll
        for (int j = 0; j < 4; ++j) xr[64 * j] = v[j] * rs * g[j];
    }
}

struct Args { const float* in[21]; float* out; unsigned char* ws; int ph_lo, ph_hi, li, pad; };
__global__ void __launch_bounds__(NWAVES * 64, 2) hyb_fwd(Args args) {
    extern __shared__ __attribute__((aligned(16))) unsigned char lds[];
    Frame F;
    F.lds = (LAS unsigned char*)lds;
    F.MISC = (volatile LAS unsigned*)(F.lds + MISC_OFF);
    F.tid = threadIdx.x; F.lane = F.tid & 63; F.wave = __builtin_amdgcn_readfirstlane(F.tid >> 6);
    F.G = gridDim.x; { const int bx = blockIdx.x; F.vcu = (F.G % 8 == 0) ? (bx % 8) * (F.G / 8) + bx / 8 : bx; }
    unsigned char* ws = args.ws;
    F.ctl = (gu32*)(ws + WS_CTL);
#define IN_(k) (args.in[k])
#define x_ IN_(0)
#define g_mix IN_(1)
#define w_in IN_(2)
#define b_gate IN_(3)
#define w_dw IN_(4)
#define b_dw IN_(5)
#define g_cln IN_(6)
#define b_cln IN_(7)
#define w_cpw IN_(8)
#define lq1 IN_(9)
#define lk1 IN_(10)
#define lq2 IN_(11)
#define lk2 IN_(12)
#define g_sub IN_(13)
#define w_apw IN_(14)
#define w_out IN_(15)
#define g_ffn IN_(16)
#define w_fg IN_(17)
#define w_fu IN_(18)
#define w_fd IN_(19)
#define g_fin IN_(20)
#define out (args.out)
#define WIN ((bf16*)(ws + WS_WIN))
#define WCA ((bf16*)(ws + WS_WCA))
#define WO ((bf16*)(ws + WS_WO))
#define WGU ((bf16*)(ws + WS_WGU))
#define WD ((bf16*)(ws + WS_WD))
#define ROPE ((float*)(ws + WS_ROPE))
#define RS1 ((float*)(ws + WS_RS1))
#define PART1 ((float*)(ws + WS_PART1))
#define PART2 ((float*)(ws + WS_PART2))
#define XB ((bf16*)(ws + WS_XB))
#define U ((bf16*)(ws + WS_U))
#define CA ((bf16*)(ws + WS_CA))
#define VP ((bf16*)(ws + WS_V))
#define KP ((bf16*)(ws + WS_K))
#define MERGED ((bf16*)(ws + WS_MERGED))
#define X1B ((bf16*)(ws + WS_X1B))
#define FF ((bf16*)(ws + WS_FF))
#define GATES ((bf16*)out)

    for (int u = F.tid; u < (LDS_BYTES - LDSCTL_OFF) / 4; u += NWAVES * 64) ((LAS unsigned*)(F.lds + LDSCTL_OFF))[u] = 0u;
    __syncthreads();
    XcdBarrier bar; bar.bar = (unsigned*)(F.ctl + CW_BAR); bar.x = 0; bar.st = nullptr;
    if (N_LAUNCHES != PER_PHASE) bar = xcd_barrier_post((unsigned*)(F.ctl + CW_BAR), F.MISC + 8);
#define GRID_BAR() do { if (N_LAUNCHES != PER_PHASE) xcd_barrier(bar); } while (0)
    const int lo = args.ph_lo, hi = args.ph_hi;
#ifndef PH_MASK
#define PH_MASK 0xff
#endif
#define IN(k) (((PH_MASK >> (k)) & 1) && lo <= (k) && (k) < hi)
#define BOTH(k) (IN(k) && IN((k) + 1))
#ifdef PROBE_A
#define STAMP(k) do { if (F.tid == 0) F.MISC[12 + (k)] = (unsigned)rt(); } while (0)
#else
#define STAMP(k) do { } while (0)
#endif
    STAMP(0);

    if (IN(0)) {
        P0Args a{x_, g_mix, w_in, w_cpw, w_apw, w_out, g_ffn, w_fg, w_fu, w_fd, WIN, WCA, WO, WGU, WD, XB, RS1, ROPE};
        p0_prologue(F, a);
        if (BOTH(0)) GRID_BAR();
        STAMP(1);
    }
    if (IN(1)) {
        pg8::Gemm g{XB, WIN, M, INC, D}; pg8::StaticOrder S; S.init(M, INC, F.G, (int)blockIdx.x);
        pg8::EpiIn E{U, CA, KP, VP, GATES, RS1, b_gate, ROPE};
        pg8::gemm_phase<pg8::EpiIn, pg8::StaticOrder, true, true>(F.lds + RING_OFF, g, S, E);
        if (BOTH(1)) GRID_BAR();
        STAMP(2);
    }
    if (IN(2)) {
#ifndef NO_CONV
        { ConvArgs ca{U, CA, w_dw, b_dw, g_cln, b_cln};
          float w0[31], w1[31];
          { const float* wp = w_dw + 2 * F.tid;
            _Pragma("unroll") for (int j = 0; j < 31; ++j) { const f32x2 t = *(const f32x2*)wp; w0[j] = t.x; w1[j] = t.y; wp += D; asm volatile("" : "+v"(wp)); } }
          _Pragma("nounroll") for (int it = F.vcu * 4; it < M / 32; it += F.G * 4) { conv_dma(F, ca, it);
              _Pragma("nounroll") for (int k = 0; k < 4; ++k) conv_item(F, ca, it + k, k < 3 ? it + k + 1 : -1, w0, w1); }
          asm volatile("s_waitcnt vmcnt(0)" ::: "memory"); __syncthreads(); }
#endif
        STAMP(10);
#ifndef NO_ATTN
        const float d1 = wave_sum(lq1[F.lane] * lk1[F.lane]), d2 = wave_sum(lq2[F.lane] * lk2[F.lane]);
        const float lam = expf(d1) - expf(d2) + 0.2f;
#ifdef ATT_V1
        for (int v = F.vcu; v < 256; v += F.G) {
            const int bh = v >> 1, sub = v & 1;
            for (int i = 0; i < 8; ++i) { const int k = i >> 1; const int qb = (i & 1) ? (2 * k + sub) : (15 - 2 * k - sub);
                att::attn_unit(bh >> 3, bh & 7, qb, CA, KP, VP, g_sub, lam, F.lds + RING_OFF); }
        }
#else
        for (int v = F.vcu; v < 256; v += F.G) {
            const int bh = v >> 1, sub = v & 1; float* osc = (float*)(ws + WS_MERGED) + (size_t)v * (NWAVES * 4096);
            for (int i = 0; i < 4; ++i) { const int k = i >> 1; const int qb = (i & 1) ? (2 * k + sub) : (7 - 2 * k - sub);
                att2::attn_unit<8>(bh >> 3, bh & 7, 0, qb, CA, KP, VP, osc, g_sub, lam, (char*)lds + RING_OFF);
                att2::attn_unit<8>(bh >> 3, bh & 7, 1, qb, CA, KP, VP, osc, g_sub, lam, (char*)lds + RING_OFF); }
        }
#endif
#endif
        if (BOTH(2)) GRID_BAR();
        STAMP(3);
    }
    if (IN(3)) {
        pg8::Gemm g{CA, WCA, M, D, 2 * D}; pg8::StaticOrder S; S.init(M, D, F.G, (int)blockIdx.x);
        pg8::EpiMerge E{GATES, MERGED};
        pg8::gemm_phase<pg8::EpiMerge, pg8::StaticOrder, true, true>(F.lds + RING_OFF, g, S, E);
        if (BOTH(3)) GRID_BAR();
        STAMP(4);
    }
    if (IN(4)) {
        pg8::Gemm g{MERGED, WO, M, D, D}; pg8::StaticOrder S; S.init(M, D, F.G, (int)blockIdx.x);
        pg8::EpiResidB E{XB, X1B, PART1};
        pg8::gemm_phase<pg8::EpiResidB, pg8::StaticOrder, true, true>(F.lds + RING_OFF, g, S, E);
        if (BOTH(4)) GRID_BAR();
        STAMP(5);
    }
    if (IN(5)) {
        pg8::Gemm g{X1B, WGU, M, 2 * DFF, D}; pg8::StaticOrder S; S.init(M, 2 * DFF, F.G, (int)blockIdx.x);
        pg8::EpiUp E{PART1, FF, DFF};
        pg8::gemm_phase<pg8::EpiUp, pg8::StaticOrder, true, true>(F.lds + RING_OFF, g, S, E);
        if (BOTH(5)) GRID_BAR();
        STAMP(6);
    }
    if (IN(6)) {
        pg8::Gemm g{FF, WD, M, D, DFF}; pg8::StaticOrder S; S.init(M, D, F.G, (int)blockIdx.x);
        pg8::EpiResidF E{X1B, out, PART2};
        pg8::gemm_phase<pg8::EpiResidF, pg8::StaticOrder, true, true>(F.lds + RING_OFF, g, S, E);
        if (BOTH(6)) GRID_BAR();
        STAMP(7);
    }
    if (IN(7)) final_rows(F, out, PART2, g_fin);
#ifdef PROBE_A
    STAMP(8);
    if (blockIdx.x == 0 && F.tid == 0) { asm volatile("s_waitcnt vmcnt(0) lgkmcnt(0)" ::: "memory"); { const float t01 = (float)(F.MISC[12 + PROBE_B] - F.MISC[12 + PROBE_A]) * 0.1f; out[0] = floorf(t01 * (1.0f / PROBE_UNIT)) + 0.5f; } }
#endif
#undef IN
#undef BOTH
#undef GRID_BAR
#undef STAMP
#undef IN_
#undef x_
#undef g_mix
#undef w_in
#undef b_gate
#undef w_dw
#undef b_dw
#undef g_cln
#undef b_cln
#undef w_cpw
#undef lq1
#undef lk1
#undef lq2
#undef lk2
#undef g_sub
#undef w_apw
#undef w_out
#undef g_ffn
#undef w_fg
#undef w_fu
#undef w_fd
#undef g_fin
#undef out
#undef WIN
#undef WCA
#undef WO
#undef WGU
#undef WD
#undef ROPE
#undef RS1
#undef PART1
#undef PART2
#undef XB
#undef U
#undef CA
#undef VP
#undef KP
#undef MERGED
#undef X1B
#undef FF
#undef GATES
}

extern "C" void kernel_launch(void* const* d_in, const int* in_sizes, int n_in, void* d_out, int out_size, void* d_ws, size_t ws_size, hipStream_t stream) {
    static int grid = 0;
    if (grid == 0) {
        if (n_in != 21 || in_sizes[0] != M * D || out_size != M * D || ws_size < WS_END) { fprintf(stderr, "kernel_launch: unexpected problem: n_in %d in0 %d out %d ws %zu; nothing launched\n", n_in, n_in > 0 ? in_sizes[0] : -1, out_size, ws_size); grid = -1; return; }
        int dev = 0, cus = 0, per_cu = 0;
        if (hipGetDevice(&dev) != hipSuccess || hipDeviceGetAttribute(&cus, hipDeviceAttributeMultiprocessorCount, dev) != hipSuccess) { fprintf(stderr, "kernel_launch: device query failed\n"); grid = -1; return; }
        if (hipFuncSetAttribute((const void*)hyb_fwd, hipFuncAttributeMaxDynamicSharedMemorySize, LDS_BYTES) != hipSuccess) { fprintf(stderr, "kernel_launch: hipFuncSetAttribute failed\n"); grid = -1; return; }
        if (hipOccupancyMaxActiveBlocksPerMultiprocessor(&per_cu, (const void*)hyb_fwd, NWAVES * 64, LDS_BYTES) != hipSuccess || per_cu < 1)
            fprintf(stderr, "kernel_launch: note: occupancy query reports %d workgroups per CU\n", per_cu);
        (void)hipGetLastError();
        grid = cus;
        if (grid > 256) grid = 256;
    }
    if (grid < 0) return;
    if (hipMemsetAsync((char*)d_ws + WS_CTL, 0, CTL_ZERO_BYTES, stream) != hipSuccess) { fprintf(stderr, "kernel_launch: hipMemsetAsync failed\n"); return; }
    Args a{};
    for (int i = 0; i < 21; ++i) a.in[i] = (const float*)d_in[i];
    a.out = (float*)d_out; a.ws = (unsigned char*)d_ws;
    if (N_LAUNCHES == 1) { a.ph_lo = 0; a.ph_hi = PER_PHASE; a.li = 0; hipLaunchKernelGGL(hyb_fwd, dim3(grid), dim3(NWAVES * 64), LDS_BYTES, stream, a); }
    else for (int li = 0; li < PER_PHASE; ++li) { a.ph_lo = li; a.ph_hi = li + 1; a.li = li; hipLaunchKernelGGL(hyb_fwd, dim3(grid), dim3(NWAVES * 64), LDS_BYTES, stream, a); }
    const hipError_t le = hipPeekAtLastError();
    if (le != hipSuccess) fprintf(stderr, "kernel_launch: launch failed: %s\n", hipGetErrorName(le));
}
```

```cpp
#include <hip/hip_runtime.h>
#include <cstdio>
#include <cstdint>
namespace pg8 {
#define PG8_LAS __attribute__((address_space(3)))
typedef unsigned short bf16_t;
typedef short bf16x8 __attribute__((ext_vector_type(8)));
typedef float f32x4 __attribute__((ext_vector_type(4)));
typedef unsigned u32x4 __attribute__((ext_vector_type(4)));
constexpr int BM = 256, BK = 64, HALF = 128, HTB = HALF * BK * 2  , STAGE_BYTES = 8 * HTB, NXCD = 8, WGM = 8;

__host__ __device__ __forceinline__ int lds_byte(int r, int c) { const int st = (r >> 4) * 2 + (c >> 5), rr = r & 15, cc = c & 31, ob = rr * 64 + cc * 2; return st * 1024 + (ob ^ (((ob >> 9) & 1) << 5)); }
__host__ __device__ __forceinline__ void stage_rc(int b, int& R, int& C) { const int st = b / 1024, sb = b % 1024, swz = sb ^ (((sb >> 9) & 1) << 5); R = (st >> 1) * 16 + swz / 64; C = (st & 1) * 32 + (swz % 64) / 2; }
__host__ __device__ __forceinline__ int perm32(int rho) { const int n = rho >> 4, i = rho & 15; return 8 * (i >> 2) + 4 * n + (i & 3); }

struct Unit { int pm, pn; };
struct Gemm { const bf16_t* A; const bf16_t* Bt; int M, N, K; };

struct StaticOrder {
    int nM, nN, nwg, G, c;
    __host__ __device__ void init(int M, int N, int G_, int c_) { nM = M / BM; nN = N / BM; nwg = nM * nN; G = G_; c = c_; }
    __host__ __device__ bool next(int i, Unit& u) const {
        const long L = (long)i * G + c; if (L >= nwg) return false;
        int wgid = (int)L; { const int q = nwg / NXCD, r = nwg % NXCD, xcd = wgid % NXCD, off = wgid / NXCD; wgid = (xcd < r ? xcd * (q + 1) : r * (q + 1) + (xcd - r) * q) + off; }
        const int nig = WGM * nN, gid = wgid / nig, fm = gid * WGM, gsz = (nM - fm) < WGM ? (nM - fm) : WGM;
        u.pm = fm + ((wgid % nig) % gsz); u.pn = (wgid % nig) / gsz; return true;
    }
    __device__ __forceinline__ void a_ready(const Unit&) const {}
    __device__ __forceinline__ void done(const Unit&) const {}
};

__device__ __forceinline__ unsigned cvt_pk_bf16(float lo, float hi) { unsigned r; asm volatile("v_cvt_pk_bf16_f32 %0, %1, %2" : "=v"(r) : "v"(lo), "v"(hi)); return r; }
__device__ __forceinline__ float bf_lo(unsigned w) { return __uint_as_float(w << 16); }
__device__ __forceinline__ float bf_hi(unsigned w) { return __uint_as_float(w & 0xffff0000u); }
constexpr float LOG2E = 1.4426950408889634f;
__device__ __forceinline__ float ex2(float x) { return __builtin_amdgcn_exp2f(x); }
__device__ __forceinline__ float rcpf_(float x) { return __builtin_amdgcn_rcpf(x); }
__device__ __forceinline__ float sigm(float x) { return rcpf_(1.f + ex2(-x * LOG2E)); }
__device__ __forceinline__ u32x4 pack8(const f32x4 a, const f32x4 b) { u32x4 w; w.x = cvt_pk_bf16(a[0], a[1]); w.y = cvt_pk_bf16(a[2], a[3]); w.z = cvt_pk_bf16(b[0], b[1]); w.w = cvt_pk_bf16(b[2], b[3]); return w; }

constexpr int SEQ_ = 2048;
constexpr float QSCALE = 0.125f * 1.4426950408889634f;

struct EpiIn {
    static constexpr bool PERM = true, AFTER_DRAIN = false, MID = false;
    bf16_t* U; bf16_t* CA; bf16_t* Kp; bf16_t* Vp; bf16_t* G; const float* rs1; const float* bgate; const float* rope;
    __device__ __forceinline__ void operator()(const f32x4 (&acc)[2][2][4][2], const Unit& u, int wr, int wc, int fr, int fq) const {
        const int pn = u.pn, rowb = u.pm * BM + wr * 64 + fr;
        if (pn < 8) {
            bf16_t* base = U + pn * 128 + wc * 32 + fq * 8;
#pragma unroll
            for (int ai = 0; ai < 2; ++ai)
#pragma unroll
                for (int m = 0; m < 4; ++m) { const int r = rowb + ai * HALF + m * 16; const float rs = rs1[r]; f32x4 o[2];
#pragma unroll
                    for (int n = 0; n < 2; ++n) { const f32x4 a = acc[ai][0][m][n] * rs, g = acc[ai][1][m][n] * rs;
#pragma unroll
                        for (int e = 0; e < 4; ++e) o[n][e] = a[e] * sigm(g[e]); }
                    *(u32x4*)(base + (size_t)r * 1024) = pack8(o[0], o[1]); }
        } else if (pn < 16) {
            const bool isq = pn < 12; const bool dorope = ((wc & 1) == 0) && (fq < 2);
#pragma unroll
            for (int ai = 0; ai < 2; ++ai)
#pragma unroll
                for (int m = 0; m < 4; ++m) { const int r = rowb + ai * HALF + m * 16; const float rs = rs1[r]; const int pos = r & (SEQ_ - 1);
                    f32x4 cs0 = {1.f, 0.f, 1.f, 0.f}, cs1 = {1.f, 0.f, 1.f, 0.f};
                    if (dorope) { const float* rp = rope + ((size_t)pos * 8 + 4 * fq) * 2; cs0 = *(const f32x4*)rp; cs1 = *(const f32x4*)(rp + 4); }
#pragma unroll
                    for (int bj = 0; bj < 2; ++bj) { f32x4 v0 = acc[ai][bj][m][0] * rs, v1 = acc[ai][bj][m][1] * rs;
                        { const float a = v0[0], b = v0[1], c = v0[2], d = v0[3];
                          v0[0] = a * cs0[0] - b * cs0[1]; v0[1] = b * cs0[0] + a * cs0[1]; v0[2] = c * cs0[2] - d * cs0[3]; v0[3] = d * cs0[2] + c * cs0[3]; }
                        { const float a = v1[0], b = v1[1], c = v1[2], d = v1[3];
                          v1[0] = a * cs1[0] - b * cs1[1]; v1[1] = b * cs1[0] + a * cs1[1]; v1[2] = c * cs1[2] - d * cs1[3]; v1[3] = d * cs1[2] + c * cs1[3]; }
                        if (isq) { v0 = v0 * QSCALE; v1 = v1 * QSCALE;
                            *(u32x4*)(CA + (size_t)r * 2048 + 1024 + (pn - 8) * 256 + bj * HALF + wc * 32 + fq * 8) = pack8(v0, v1);
                        } else { const int b_ = r >> 11, tile = pos >> 6, row = pos & 63, h = 2 * (pn - 12) + bj, comp = wc >> 1, chunk = 4 * (wc & 1) + fq;
                            *(u32x4*)(Kp + ((size_t)((((b_ * 8 + h) * 32 + tile) * 2 + comp) * 8 + chunk) * 64 + row) * 8) = pack8(v0, v1); } } }
        } else if (pn < 20) {
#pragma unroll
            for (int ai = 0; ai < 2; ++ai)
#pragma unroll
                for (int m = 0; m < 4; ++m) { const int r = rowb + ai * HALF + m * 16; const float rs = rs1[r]; const int pos = r & (SEQ_ - 1), b_ = r >> 11, tile = pos >> 6, ks = (pos & 63) >> 4, r16 = pos & 15;
#pragma unroll
                    for (int bj = 0; bj < 2; ++bj) { const int h = 2 * (pn - 16) + bj; const f32x4 v0 = acc[ai][bj][m][0] * rs, v1 = acc[ai][bj][m][1] * rs;
                        *(u32x4*)(Vp + ((size_t)(((b_ * 8 + h) * 32 + tile) * 16 + wc * 4 + ks) * 16 + r16) * 32 + fq * 8) = pack8(v0, v1); } }
        } else {
            const int ch = (pn - 20) * 128 + wc * 32 + fq * 8;
            const f32x4 bc0 = *(const f32x4*)(bgate + ch), bc1 = *(const f32x4*)(bgate + ch + 4), ba0 = *(const f32x4*)(bgate + 1024 + ch), ba1 = *(const f32x4*)(bgate + 1024 + ch + 4);
#pragma unroll
            for (int ai = 0; ai < 2; ++ai)
#pragma unroll
                for (int m = 0; m < 4; ++m) { const int r = rowb + ai * HALF + m * 16; const float rs = rs1[r]; f32x4 rt[2], ga[2];
#pragma unroll
                    for (int n = 0; n < 2; ++n) { const f32x4 xc = acc[ai][0][m][n] * rs + (n ? bc1 : bc0), xa = acc[ai][1][m][n] * rs + (n ? ba1 : ba0);
#pragma unroll
                        for (int e = 0; e < 4; ++e) { const float ea = ex2(fminf(-xa[e] * LOG2E, 80.f)), ec = ex2(-xc[e] * LOG2E); ga[n][e] = rcpf_(1.f + ea); rt[n][e] = (1.f + ea) * rcpf_(1.f + ec); } }
                    *(u32x4*)(G + (size_t)r * 2048 + ch) = pack8(rt[0], rt[1]);
                    *(u32x4*)(G + (size_t)r * 2048 + 1024 + ch) = pack8(ga[0], ga[1]); }
        }
    }
};

struct EpiMerge {
    static constexpr bool PERM = true, AFTER_DRAIN = false, MID = true;
    const bf16_t* G; bf16_t* O;
    __device__ __forceinline__ void mid(f32x4 (&acc)[2][2][4][2], const Unit& u, int wr, int wc, int fr, int fq) const {
        asm volatile("" : "+v"(fr), "+v"(fq));
        const int rowb = u.pm * BM + wr * 64 + fr, col = u.pn * BM + wc * 32 + fq * 8;
#pragma unroll
        for (int ai = 0; ai < 2; ++ai)
#pragma unroll
            for (int m = 0; m < 4; ++m) { const bf16_t* gp = G + (size_t)(rowb + ai * HALF + m * 16) * 2048 + col;
#pragma unroll
                for (int bj = 0; bj < 2; ++bj) { const u32x4 w = *(const u32x4*)(gp + bj * HALF);
                    acc[ai][bj][m][0] *= (f32x4){bf_lo(w.x), bf_hi(w.x), bf_lo(w.y), bf_hi(w.y)}; acc[ai][bj][m][1] *= (f32x4){bf_lo(w.z), bf_hi(w.z), bf_lo(w.w), bf_hi(w.w)}; }
                if (m & 1) asm volatile("" ::: "memory"); }
    }
    __device__ __forceinline__ void operator()(const f32x4 (&acc)[2][2][4][2], const Unit& u, int wr, int wc, int fr, int fq) const {
        const int rowb = u.pm * BM + wr * 64 + fr, col = u.pn * BM + wc * 32 + fq * 8;
#pragma unroll
        for (int ai = 0; ai < 2; ++ai)
#pragma unroll
            for (int m = 0; m < 4; ++m) { const int r = rowb + ai * HALF + m * 16; const bf16_t* gp = G + (size_t)r * 2048 + 1024 + col;
#pragma unroll
                for (int bj = 0; bj < 2; ++bj) { const u32x4 w = *(const u32x4*)(gp + bj * HALF);
                    const f32x4 v0 = acc[ai][bj][m][0] * (f32x4){bf_lo(w.x), bf_hi(w.x), bf_lo(w.y), bf_hi(w.y)}, v1 = acc[ai][bj][m][1] * (f32x4){bf_lo(w.z), bf_hi(w.z), bf_lo(w.w), bf_hi(w.w)};
                    *(u32x4*)(O + (size_t)r * 1024 + col + bj * HALF) = pack8(v0, v1); } }
    }
};

struct EpiResidB {
    static constexpr bool PERM = true, AFTER_DRAIN = false, MID = false;
    const bf16_t* base; bf16_t* ob; float* part;
    __device__ __forceinline__ void operator()(const f32x4 (&acc)[2][2][4][2], const Unit& u, int wr, int wc, int fr, int fq) const {
        const int rowb = u.pm * BM + wr * 64 + fr, col0 = u.pn * BM + wc * 32 + 8 * fq;
#pragma unroll
        for (int ai = 0; ai < 2; ++ai)
#pragma unroll
            for (int m = 0; m < 4; ++m) { const int r = rowb + ai * HALF + m * 16; const size_t off = (size_t)r * 1024 + col0; float ss = 0.f;
#pragma unroll
                for (int bj = 0; bj < 2; ++bj) { const u32x4 w = *(const u32x4*)(base + off + bj * HALF);
                    const f32x4 v0 = acc[ai][bj][m][0] + (f32x4){bf_lo(w.x), bf_hi(w.x), bf_lo(w.y), bf_hi(w.y)}, v1 = acc[ai][bj][m][1] + (f32x4){bf_lo(w.z), bf_hi(w.z), bf_lo(w.w), bf_hi(w.w)};
                    ss += ((v0[0] * v0[0] + v0[1] * v0[1]) + (v0[2] * v0[2] + v0[3] * v0[3])) + ((v1[0] * v1[0] + v1[1] * v1[1]) + (v1[2] * v1[2] + v1[3] * v1[3]));
                    *(u32x4*)(ob + off + bj * HALF) = pack8(v0, v1); }
                ss += __shfl_xor(ss, 16); ss += __shfl_xor(ss, 32);
                if (fq == 0) part[(size_t)r * 16 + u.pn * 4 + wc] = ss; }
    }
};
struct EpiResidF {
    static constexpr bool PERM = true, AFTER_DRAIN = false, MID = false;
    const bf16_t* base; float* out; float* part;
    __device__ __forceinline__ void operator()(const f32x4 (&acc)[2][2][4][2], const Unit& u, int wr, int wc, int fr, int fq) const {
        const int rowb = u.pm * BM + wr * 64 + fr, col0 = u.pn * BM + wc * 32 + 8 * fq;
#pragma unroll
        for (int ai = 0; ai < 2; ++ai)
#pragma unroll
            for (int m = 0; m < 4; ++m) { const int r = rowb + ai * HALF + m * 16; const size_t off = (size_t)r * 1024 + col0; float ss = 0.f;
#pragma unroll
                for (int bj = 0; bj < 2; ++bj) { const u32x4 w = *(const u32x4*)(base + off + bj * HALF);
                    const f32x4 v0 = acc[ai][bj][m][0] + (f32x4){bf_lo(w.x), bf_hi(w.x), bf_lo(w.y), bf_hi(w.y)}, v1 = acc[ai][bj][m][1] + (f32x4){bf_lo(w.z), bf_hi(w.z), bf_lo(w.w), bf_hi(w.w)};
                    ss += ((v0[0] * v0[0] + v0[1] * v0[1]) + (v0[2] * v0[2] + v0[3] * v0[3])) + ((v1[0] * v1[0] + v1[1] * v1[1]) + (v1[2] * v1[2] + v1[3] * v1[3]));
                    *(f32x4*)(out + off + bj * HALF) = v0; *(f32x4*)(out + off + bj * HALF + 4) = v1; }
                ss += __shfl_xor(ss, 16); ss += __shfl_xor(ss, 32);
                if (fq == 0) part[(size_t)r * 16 + u.pn * 4 + wc] = ss; }
    }
};

struct EpiUp {
    static constexpr bool PERM = true, AFTER_DRAIN = false, MID = false;
    const float* part; bf16_t* FF; int ldf;
    __device__ __forceinline__ void operator()(const f32x4 (&acc)[2][2][4][2], const Unit& u, int wr, int wc, int fr, int fq) const {
        const int rowb = u.pm * BM + wr * 64 + fr; bf16_t* base = FF + u.pn * 128 + wc * 32 + fq * 8;
#pragma unroll
        for (int ai = 0; ai < 2; ++ai)
#pragma unroll
            for (int m = 0; m < 4; ++m) { const int r = rowb + ai * HALF + m * 16; const f32x4 pv = *(const f32x4*)(part + (size_t)r * 16 + 4 * fq);
                float s = (pv[0] + pv[1]) + (pv[2] + pv[3]); s += __shfl_xor(s, 16); s += __shfl_xor(s, 32);
                const float rs = 1.0f / sqrtf(s * (1.0f / 1024.0f) + 1e-6f); f32x4 o[2];
#pragma unroll
                for (int n = 0; n < 2; ++n) { const f32x4 g = acc[ai][0][m][n] * rs, up = acc[ai][1][m][n] * rs;
#pragma unroll
                    for (int e = 0; e < 4; ++e) o[n][e] = g[e] * sigm(g[e]) * up[e]; }
                *(u32x4*)(base + (size_t)r * ldf) = pack8(o[0], o[1]); }
    }
};

template <class Epi, class Sched, bool ALIGN_EPI = false, bool SP2 = false>
__device__ __forceinline__ void gemm_phase(PG8_LAS unsigned char* lds, const Gemm g, const Sched& S, const Epi& E) {
    const int tid = threadIdx.x, wid = __builtin_amdgcn_readfirstlane(tid >> 6), lane = tid & 63, wr = wid >> 2, wc = wid & 3, fr = lane & 15, fq = lane >> 4;
    const int K = g.K, nt = K / BK;
    unsigned voffA[2], voffB[2];
#pragma unroll
    for (int i = 0; i < 2; ++i) { int R, C; stage_rc(tid * 16 + i * 8192, R, C); const int Rb = Epi::PERM ? ((R & ~31) + perm32(R & 31)) : R;
        voffA[i] = (unsigned)(R * K + C) * 2u; voffB[i] = (unsigned)(Rb * K + C) * 2u; }
    const size_t kstep = (size_t)(BK * 2);
    const size_t hstep = (size_t)HALF * K * 2;
    const size_t tstep = 2 * hstep;
    const unsigned ldsw = (unsigned)wid * 1024u;
    const int aoff = lds_byte(wr * 64 + fr, fq * 8), boff = lds_byte(wc * 32 + fr, fq * 8);
#define PG8_SA(b, h) (((b) * 2 + (h)) * HTB)
#define PG8_SB(b, h) ((4 + (b) * 2 + (h)) * HTB)
#define PG8_STAGE(bufoff, gbase, voff) do { _Pragma("unroll") for (int _i = 0; _i < 2; ++_i) \
        __builtin_amdgcn_global_load_lds((const unsigned*)((const char*)(gbase) + (voff)[_i]), (PG8_LAS unsigned*)(lds + (bufoff) + ldsw + _i * 8192), 16, 0, 0); } while (0)
#define PG8_LDA(dst, b, h) do { _Pragma("unroll") for (int m = 0; m < 4; ++m) _Pragma("unroll") for (int k = 0; k < 2; ++k) dst[m][k] = *(const PG8_LAS bf16x8*)(lds + PG8_SA(b, h) + aoff + m * 2048 + k * 1024); } while (0)
#define PG8_LDB(dst, b, h) do { _Pragma("unroll") for (int n = 0; n < 2; ++n) _Pragma("unroll") for (int k = 0; k < 2; ++k) dst[n][k] = *(const PG8_LAS bf16x8*)(lds + PG8_SB(b, h) + boff + n * 2048 + k * 1024); } while (0)
#define PG8_MMA(ai, bj, At, Bt) do { __builtin_amdgcn_s_setprio(1); _Pragma("unroll") for (int m = 0; m < 4; ++m) _Pragma("unroll") for (int n = 0; n < 2; ++n) _Pragma("unroll") for (int k = 0; k < 2; ++k) \
        acc[ai][bj][m][n] = __builtin_amdgcn_mfma_f32_16x16x32_bf16(Bt[n][k], At[m][k], acc[ai][bj][m][n], 0, 0, 0); __builtin_amdgcn_s_setprio(0); } while (0)
#define PG8_WAIT_V(n) asm volatile("s_waitcnt vmcnt(" #n ")" ::: "memory")
#define PG8_WAIT_L(n) asm volatile("s_waitcnt lgkmcnt(" #n ")" ::: "memory")
#define PG8_BAR __builtin_amdgcn_s_barrier()
#define PG8_SCHED __builtin_amdgcn_sched_barrier(0)
    Unit cur, nxt; int ui = 0;
    if (!S.next(0, cur)) return;
    f32x4 acc[2][2][4][2];
#pragma unroll
    for (int a = 0; a < 2; ++a)
#pragma unroll
        for (int b = 0; b < 2; ++b)
#pragma unroll
            for (int m = 0; m < 4; ++m)
#pragma unroll
                for (int n = 0; n < 2; ++n) acc[a][b][m][n] = (f32x4){0.f, 0.f, 0.f, 0.f};
    bf16x8 At[4][2], B0[2][2], B1[2][2];
    const char* cA = (const char*)g.A + (size_t)cur.pm * tstep; const char* cB = (const char*)g.Bt + (size_t)cur.pn * tstep;
    S.a_ready(cur);
    if constexpr (SP2) {
        PG8_STAGE(PG8_SB(0, 0), cB, voffB); PG8_STAGE(PG8_SB(0, 1), cB + hstep, voffB); PG8_STAGE(PG8_SA(0, 0), cA, voffA); PG8_STAGE(PG8_SA(0, 1), cA + hstep, voffA);
        if (wr == 1) PG8_BAR;
        PG8_WAIT_V(2); PG8_BAR;
        PG8_STAGE(PG8_SB(1, 0), cB + kstep, voffB); PG8_STAGE(PG8_SA(1, 0), cA + kstep, voffA); PG8_STAGE(PG8_SB(1, 1), cB + hstep + kstep, voffB);
        PG8_WAIT_V(6); PG8_BAR;
    } else {
        PG8_STAGE(PG8_SB(0, 0), cB, voffB); PG8_STAGE(PG8_SA(0, 0), cA, voffA); PG8_STAGE(PG8_SB(0, 1), cB + hstep, voffB); PG8_STAGE(PG8_SA(0, 1), cA + hstep, voffA);
        if (wr == 1) PG8_BAR;
        PG8_WAIT_V(4); PG8_BAR;
        PG8_STAGE(PG8_SB(1, 0), cB + kstep, voffB); PG8_STAGE(PG8_SA(1, 0), cA + kstep, voffA); PG8_STAGE(PG8_SB(1, 1), cB + hstep + kstep, voffB);
        PG8_WAIT_V(6); PG8_BAR;
    }
    for (;;) {
        const bool has_next = S.next(ui + 1, nxt);
        const char* nA = has_next ? (const char*)g.A + (size_t)nxt.pm * tstep : cA; const char* nB = has_next ? (const char*)g.Bt + (size_t)nxt.pn * tstep : cB;
        for (int t = 0; t < nt; t += 2) {
            if constexpr (Epi::MID) { if (t == (nt >> 1)) E.mid(acc, cur, wr, wc, fr, fq); }
            const bool last = (t == nt - 2);
            const char* a1 = cA + (size_t)(t + 1) * kstep;
            const char* a2 = last ? nA : cA + (size_t)(t + 2) * kstep; const char* b2 = last ? nB : cB + (size_t)(t + 2) * kstep;
            const char* a3 = a2 + kstep; const char* b3 = b2 + kstep;
            if (last && has_next) S.a_ready(nxt);
            if constexpr (SP2) {
            PG8_LDB(B0, 0, 0); PG8_LDB(B1, 0, 1); PG8_SCHED; PG8_LDA(At, 0, 0); PG8_STAGE(PG8_SA(1, 1), a1 + hstep, voffA);
            PG8_WAIT_V(8); PG8_WAIT_L(0); PG8_BAR; PG8_MMA(0, 0, At, B0); PG8_MMA(0, 1, At, B1); PG8_BAR; PG8_SCHED;
            PG8_LDA(At, 0, 1); PG8_STAGE(PG8_SB(0, 0), b2, voffB); PG8_STAGE(PG8_SB(0, 1), b2 + hstep, voffB); PG8_STAGE(PG8_SA(0, 0), a2, voffA);
            PG8_WAIT_V(8); PG8_WAIT_L(0); PG8_BAR; PG8_MMA(1, 0, At, B0); PG8_MMA(1, 1, At, B1); PG8_BAR; PG8_SCHED;
            PG8_LDB(B0, 1, 0); PG8_LDB(B1, 1, 1); PG8_SCHED; PG8_LDA(At, 1, 0); PG8_STAGE(PG8_SA(0, 1), a2 + hstep, voffA);
            PG8_WAIT_V(8); PG8_WAIT_L(0); PG8_BAR; PG8_MMA(0, 0, At, B0); PG8_MMA(0, 1, At, B1); PG8_BAR; PG8_SCHED;
            PG8_LDA(At, 1, 1); PG8_STAGE(PG8_SB(1, 0), b3, voffB); PG8_STAGE(PG8_SB(1, 1), b3 + hstep, voffB); PG8_STAGE(PG8_SA(1, 0), a3, voffA);
            PG8_WAIT_V(8); PG8_WAIT_L(0); PG8_BAR; PG8_MMA(1, 0, At, B0); PG8_MMA(1, 1, At, B1); PG8_BAR; PG8_SCHED;
            } else {
            PG8_LDB(B0, 0, 0); PG8_SCHED; PG8_LDA(At, 0, 0); PG8_STAGE(PG8_SA(1, 1), a1 + hstep, voffA);
            PG8_WAIT_L(8); PG8_BAR; PG8_WAIT_L(0); PG8_MMA(0, 0, At, B0); PG8_BAR; PG8_SCHED;
            PG8_LDB(B1, 0, 1); PG8_STAGE(PG8_SB(0, 0), b2, voffB);
            PG8_BAR; PG8_WAIT_L(0); PG8_MMA(0, 1, At, B1); PG8_BAR;
            PG8_LDA(At, 0, 1); PG8_STAGE(PG8_SA(0, 0), a2, voffA);
            PG8_BAR; PG8_WAIT_L(0); PG8_MMA(1, 0, At, B0); PG8_BAR; PG8_SCHED;
            PG8_STAGE(PG8_SB(0, 1), b2 + hstep, voffB);
            PG8_WAIT_V(6); PG8_BAR; PG8_MMA(1, 1, At, B1); PG8_BAR;
            PG8_LDB(B0, 1, 0); PG8_SCHED; PG8_LDA(At, 1, 0); PG8_STAGE(PG8_SA(0, 1), a2 + hstep, voffA);
            PG8_WAIT_L(8); PG8_BAR; PG8_WAIT_L(0); PG8_MMA(0, 0, At, B0); PG8_BAR; PG8_SCHED;
            PG8_LDB(B1, 1, 1); PG8_STAGE(PG8_SB(1, 0), b3, voffB);
            PG8_BAR; PG8_WAIT_L(0); PG8_MMA(0, 1, At, B1); PG8_BAR;
            PG8_LDA(At, 1, 1); PG8_STAGE(PG8_SA(1, 0), a3, voffA);
            PG8_BAR; PG8_WAIT_L(0); PG8_MMA(1, 0, At, B0); PG8_BAR; PG8_SCHED;
            PG8_STAGE(PG8_SB(1, 1), b3 + hstep, voffB);
            PG8_WAIT_V(6); PG8_BAR; PG8_MMA(1, 1, At, B1); PG8_BAR;
            }
        }
        if constexpr (ALIGN_EPI) { if (wr == 0) PG8_BAR; }
        if constexpr (!Epi::AFTER_DRAIN) { E(acc, cur, wr, wc, fr, fq); S.done(cur); }
        if (!has_next) break;
#pragma unroll
        for (int a = 0; a < 2; ++a)
#pragma unroll
            for (int b = 0; b < 2; ++b)
#pragma unroll
                for (int m = 0; m < 4; ++m)
#pragma unroll
                    for (int n = 0; n < 2; ++n) acc[a][b][m][n] = (f32x4){0.f, 0.f, 0.f, 0.f};
        cur = nxt; cA = nA; cB = nB; ++ui;
        if constexpr (ALIGN_EPI) { if (wr == 1) PG8_BAR; }
    }
    PG8_WAIT_V(0);
    if constexpr (!ALIGN_EPI) { if (wr == 0) PG8_BAR; }
    PG8_BAR;
    if constexpr (Epi::AFTER_DRAIN) { E.fused(acc, cur, wr, wc, fr, fq, lds, wid, lane); S.done(cur); }
#undef PG8_SA
#undef PG8_SB
#undef PG8_STAGE
#undef PG8_LDA
#undef PG8_LDB
#undef PG8_MMA
#undef PG8_WAIT_V
#undef PG8_WAIT_L
#undef PG8_BAR
#undef PG8_SCHED
}
}

constexpr int NWAVES = 8;
#ifndef MK_N_LAUNCHES
#define MK_N_LAUNCHES 1
#endif
constexpr int PER_PHASE = 8;
constexpr int N_LAUNCHES = MK_N_LAUNCHES;

constexpr int BATCH = 16, SEQ = 2048, D = 1024, M = BATCH * SEQ, NH = 8, DFF = 2816, INC = 7168;
constexpr float RMS_EPS = 1e-6f, LN_EPS = 1e-5f;

constexpr size_t MiB = 1u << 20;
constexpr size_t WS_CTL = 0, CTL_ZERO_BYTES = 1 * MiB;
constexpr size_t WS_WIN = 2 * MiB;
constexpr size_t WS_WCA = 16 * MiB;
constexpr size_t WS_WO = 20 * MiB;
constexpr size_t WS_WGU = 22 * MiB;
constexpr size_t WS_WD = 33 * MiB;
constexpr size_t WS_ROPE = 40 * MiB;
constexpr size_t WS_RS1 = 40 * MiB + 256 * 1024;
constexpr size_t WS_PART1 = 41 * MiB, WS_PART2 = 43 * MiB;
constexpr size_t WS_XB = 48 * MiB;
constexpr size_t WS_U = 112 * MiB;
constexpr size_t WS_CA = 176 * MiB;
constexpr size_t WS_V = 304 * MiB;
constexpr size_t WS_K = 368 * MiB;
constexpr size_t WS_MERGED = 432 * MiB;
constexpr size_t WS_END = 496 * MiB;
constexpr size_t WS_X1B = WS_U, WS_FF = WS_CA;
static_assert(WS_WD + (size_t)D * DFF * 2 <= WS_ROPE && WS_FF + (size_t)M * DFF * 2 <= WS_K && WS_PART2 + (size_t)M * 64 <= WS_XB, "d_ws map");
constexpr int CW_TMO = 0, CW_CODE = 1;
constexpr int CW_BAR = 4096;

constexpr int RING_OFF = 0, RING_BYTES = 147456;
constexpr int LDSCTL_OFF = RING_BYTES, MISC_OFF = LDSCTL_OFF + 320;
constexpr int LDS_BYTES = 155648;
static_assert(MISC_OFF + 128 <= LDS_BYTES, "LDS map");
#define GAS __attribute__((address_space(1)))
#define LAS __attribute__((address_space(3)))
typedef unsigned short bf16;
typedef unsigned v4u __attribute__((ext_vector_type(4)));
typedef float f32x4 __attribute__((ext_vector_type(4)));
typedef short bf16x8 __attribute__((ext_vector_type(8)));
typedef GAS unsigned gu32;
typedef GAS unsigned long long gu64;
#define RLX_AGENT __ATOMIC_RELAXED, __HIP_MEMORY_SCOPE_AGENT
#define LDS_WAIT() asm volatile("s_waitcnt lgkmcnt(0)" ::: "memory")
#define VM_WAIT() asm volatile("s_waitcnt vmcnt(0)" ::: "memory")
__device__ __forceinline__ unsigned long long rt() { return __builtin_amdgcn_s_memrealtime(); }
__device__ __forceinline__ unsigned f2bf(float f) { unsigned u = __builtin_bit_cast(unsigned, f); return (u + 0x7fffu + ((u >> 16) & 1u)) >> 16; }
__device__ __forceinline__ unsigned pk2(float lo, float hi) { return f2bf(lo) | (f2bf(hi) << 16); }

#define XB_TMO      128
#define XB_XCNT(j)  (256  + 64 * (j))
#define XB_XSUB(j)  (1280 + 64 * (j))
#define XB_XGEN(j)  (2304 + 64 * (j))
#define XB_TOP      3328
#define XB_TOPGEN   3392
#define XCD_BAR_WORDS 3456
#define XB_SPIN_CAP (1u << 18)

__device__ __forceinline__ unsigned xb_ld(unsigned* p)              { return __hip_atomic_load(p, __ATOMIC_RELAXED, __HIP_MEMORY_SCOPE_AGENT); }
__device__ __forceinline__ unsigned xb_add(unsigned* p, unsigned v) { return __hip_atomic_fetch_add(p, v, __ATOMIC_RELAXED, __HIP_MEMORY_SCOPE_AGENT); }
__device__ __forceinline__ unsigned xb_xcc_id() { return (unsigned)__builtin_amdgcn_s_getreg((3 << 11) | 20) & 0xFu; }
#define XB_SPIN(cond, bar) do { unsigned _sp = 0; while (cond) { __builtin_amdgcn_s_sleep(1); \
    if ((++_sp & 255u) == 0u) { if (xb_ld(&(bar)[XB_TMO])) break; if (_sp > XB_SPIN_CAP) { atomicAdd(&(bar)[XB_TMO], 1u); break; } } } } while (0)

struct XcdBarrier {
    unsigned* bar; unsigned x;
    volatile LAS unsigned* st;
};

__device__ __forceinline__ XcdBarrier xcd_barrier_post(unsigned* bar, volatile LAS unsigned* st) {
    XcdBarrier b; b.bar = bar; b.x = xb_xcc_id(); b.st = st;
    if (threadIdx.x == 0) (void)xb_add(&bar[XB_XCNT(b.x)], 1u);
    return b;
}
__device__ __forceinline__ void xcd_barrier_complete(unsigned* bar, unsigned x, unsigned& nloc, unsigned& nx) {
    const unsigned G = gridDim.x * gridDim.y * gridDim.z;
    unsigned sum, cnt, mine, sp = 0u;
    for (;;) {
        sum = 0u; cnt = 0u; mine = 0u;
#pragma unroll
        for (unsigned j = 0; j < 16; ++j) { const unsigned c = xb_ld(&bar[XB_XCNT(j)]); sum += c; cnt += (c > 0u) ? 1u : 0u; mine = (j == x) ? c : mine; }
        if (sum == G) break;
        __builtin_amdgcn_s_sleep(1);
        if ((++sp & 255u) == 0u) { if (xb_ld(&bar[XB_TMO])) break; if (sp > XB_SPIN_CAP) { atomicAdd(&bar[XB_TMO], 1u); break; } }
    }
    nloc = mine > 0u ? mine : 1u; nx = cnt > 0u ? cnt : 1u;
}

__device__ __forceinline__ void xcd_barrier(const XcdBarrier& b) {
    asm volatile("s_waitcnt vmcnt(0)" ::: "memory");
    __syncthreads();
    if (threadIdx.x == 0) {
        unsigned* bar = b.bar;
        __builtin_amdgcn_s_waitcnt(0);
        unsigned nloc = b.st[0], nx = b.st[1];
        if (nloc == 0u) { xcd_barrier_complete(bar, b.x, nloc, nx); b.st[0] = nloc; b.st[1] = nx; }
        const unsigned old = xb_add(&bar[XB_XSUB(b.x)], 1u);
        const unsigned gen = old / nloc;
        if (old + 1u == (gen + 1u) * nloc) {
            __builtin_amdgcn_fence(__ATOMIC_RELEASE, "agent");
            asm volatile("s_waitcnt vmcnt(0)" ::: "memory");
            const unsigned og = xb_add(&bar[XB_TOP], 1u);
            const unsigned tg = og / nx;
            if (og + 1u == (tg + 1u) * nx) xb_add(&bar[XB_TOPGEN], 1u);
            else XB_SPIN(xb_ld(&bar[XB_TOPGEN]) == tg, bar);
            __builtin_amdgcn_fence(__ATOMIC_ACQUIRE, "agent");
            xb_add(&bar[XB_XGEN(b.x)], 1u);
            asm volatile("s_waitcnt vmcnt(0)" ::: "memory");
        } else {
            XB_SPIN(xb_ld(&bar[XB_XGEN(b.x)]) == gen, bar);
            __builtin_amdgcn_fence(__ATOMIC_ACQUIRE, "agent");
            asm volatile("s_waitcnt vmcnt(0)" ::: "memory");
        }
    }
    __syncthreads();
}

struct Frame {
    LAS unsigned char* lds;
    volatile LAS unsigned* MISC;
    gu32* ctl;
    int tid, lane, wave;
    int vcu, G;
};

__device__ __forceinline__ float wave_sum(float v) {
#pragma unroll
    for (int o = 1; o < 64; o <<= 1) v += __shfl_xor(v, o);
    return v;
}

__device__ __forceinline__ int map_in(int n) {
    if (n < 1024) return ((n >> 7) << 8) + (n & 127);
    if (n < 2048) { const int c = n - 1024; return ((c >> 7) << 8) + 128 + (c & 127); }
    if (n < 4096) { const int d = n & 63; const int dp = d < 16 ? (2 * (d & 7) + (d >> 3)) : d; return n - d + dp; }
    if (n < 5120) return n;
    if (n < 6144) { const int c = n - 5120; return 5120 + ((c >> 7) << 8) + (c & 127); }
    { const int c = n - 6144; return 5120 + ((c >> 7) << 8) + 128 + (c & 127); }
}
template <int MAP> __device__ __forceinline__ int maprow(int n) {
    if (MAP == 1) return map_in(n);
    if (MAP == 2) return ((n >> 7) << 8) + (n & 127);
    if (MAP == 3) return ((n >> 7) << 8) + 128 + (n & 127);
    return n;
}
template <int MAP> __device__ __forceinline__ void p0_transpose_item(const float* W, int K, int N, bf16* WT, int ldt, int koff, const float* g, LAS float* scr, int item, int lane) {
    const int nblk = N / 32, kb = item / nblk, nb = item % nblk, k0 = 64 * kb, n0 = 32 * nb;
    float wv[32];
#pragma unroll
    for (int i = 0; i < 32; ++i) { const int kk = 2 * i + (lane >> 5); wv[i] = W[(size_t)(k0 + kk) * N + n0 + (lane & 31)]; }
    if (g) {
#pragma unroll
        for (int i = 0; i < 32; ++i) wv[i] *= g[k0 + 2 * i + (lane >> 5)]; }
#pragma unroll
    for (int i = 0; i < 32; ++i) { const int kk = 2 * i + (lane >> 5); scr[kk * 33 + (lane & 31)] = wv[i]; }
    LDS_WAIT(); asm volatile("" ::: "memory");
    const int c = lane & 7;
#pragma unroll
    for (int j = 0; j < 4; ++j) { const int n = (lane >> 3) + 8 * j; const LAS float* s = scr + (8 * c) * 33 + n;
        v4u o; o.x = pk2(s[0 * 33], s[1 * 33]); o.y = pk2(s[2 * 33], s[3 * 33]); o.z = pk2(s[4 * 33], s[5 * 33]); o.w = pk2(s[6 * 33], s[7 * 33]);
        *(GAS v4u*)(WT + (size_t)maprow<MAP>(n0 + n) * ldt + koff + k0 + 8 * c) = o; }
    LDS_WAIT(); asm volatile("" ::: "memory");
}
template <int NR> __device__ __forceinline__ void p0_rows(const float* xrow, bf16* orow, float* rs, int lane) {
    f32x4 v[NR][4]; float s[NR];
#pragma unroll
    for (int r = 0; r < NR; ++r)
#pragma unroll
        for (int j = 0; j < 4; ++j) v[r][j] = ((const GAS f32x4*)(xrow + (size_t)r * D) + lane)[64 * j];
#pragma unroll
    for (int r = 0; r < NR; ++r) { s[r] = 0.f;
#pragma unroll
        for (int j = 0; j < 4; ++j) s[r] += (v[r][j].x * v[r][j].x + v[r][j].y * v[r][j].y) + (v[r][j].z * v[r][j].z + v[r][j].w * v[r][j].w);
        s[r] = wave_sum(s[r]); }
#pragma unroll
    for (int r = 0; r < NR; ++r) { if (lane == 0) rs[r] = 1.f / sqrtf(s[r] * (1.f / D) + RMS_EPS);
        GAS unsigned long long* o8 = (GAS unsigned long long*)(orow + (size_t)r * D) + lane;
#pragma unroll
        for (int j = 0; j < 4; ++j) o8[64 * j] = (unsigned long long)pk2(v[r][j].x, v[r][j].y) | ((unsigned long long)pk2(v[r][j].z, v[r][j].w) << 32); }
}
__device__ __forceinline__ void rope_entry(int e, float* rope) {
    const int pos = e >> 3, i = e & 7;
    const float invf = i == 0 ? 1.0f : i == 1 ? 0.1939227432012558f : i == 2 ? 0.03760603070259094f : i == 3 ? 0.007292664609849453f : i == 4 ? 0.0014142135623842478f
                     : i == 5 ? 0.00027424818836152554f : i == 6 ? 5.3182957344688475e-05f : 1.0313385246263351e-05f;
    const float angf = (float)pos * invf; const double a = (double)angf;
    const double kq = __builtin_rint(a * 0.63661977236758134308);
    double r = __builtin_fma(-kq, 1.57079632679489655800, a); r = __builtin_fma(-kq, 6.12323399573676603587e-17, r);
    const double r2 = r * r;
    double sp = -7.6471637318198164759e-13; sp = sp * r2 + 1.6059043836821614599e-10; sp = sp * r2 - 2.5052108385441718775e-08; sp = sp * r2 + 2.7557319223985890653e-06;
    sp = sp * r2 - 1.9841269841269841270e-04; sp = sp * r2 + 8.3333333333333333333e-03; sp = sp * r2 - 1.6666666666666666667e-01; const double sn = r + r * r2 * sp;
    double cp = 4.7794773323873852974e-14; cp = cp * r2 - 1.1470745597729724714e-11; cp = cp * r2 + 2.0876756987868098979e-09; cp = cp * r2 - 2.7557319223985890653e-07;
    cp = cp * r2 + 2.4801587301587301587e-05; cp = cp * r2 - 1.3888888888888888889e-03; cp = cp * r2 + 4.1666666666666666667e-02; cp = cp * r2 - 0.5; const double cs = 1.0 + r2 * cp;
    const int q = (int)((long long)kq & 3);
    const double c = q == 0 ? cs : q == 1 ? -sn : q == 2 ? -cs : sn, s = q == 0 ? sn : q == 1 ? cs : q == 2 ? -sn : -cs;
    rope[2 * e] = (float)c; rope[2 * e + 1] = (float)s;
}
struct P0Args { const float *x, *g_mix, *w_in, *w_cpw, *w_apw, *w_out, *g_ffn, *w_fg, *w_fu, *w_fd; bf16 *WIN, *WCA, *WO, *WGU, *WD, *XB; float *rs1, *rope; };
__device__ __forceinline__ void p0_prologue(Frame& F, const P0Args& a) {
    LAS float* scr = (LAS float*)(F.lds + RING_OFF + F.wave * 16384);
    const int gw = F.vcu * NWAVES + F.wave, NGW = F.G * NWAVES;
    constexpr int I_IN = (D / 64) * (INC / 32), I_SQ = (D / 64) * (D / 32), I_GU = (D / 64) * (DFF / 32), I_DN = (DFF / 64) * (D / 32);
    constexpr int NITEMS = I_IN + 3 * I_SQ + 2 * I_GU + I_DN;
    for (int it = gw; it < NITEMS; it += NGW) {
        int r = it;
        if (r < I_IN) { p0_transpose_item<1>(a.w_in, D, INC, a.WIN, D, 0, a.g_mix, scr, r, F.lane); continue; } r -= I_IN;
        if (r < I_SQ) { p0_transpose_item<0>(a.w_cpw, D, D, a.WCA, 2 * D, 0, nullptr, scr, r, F.lane); continue; } r -= I_SQ;
        if (r < I_SQ) { p0_transpose_item<0>(a.w_apw, D, D, a.WCA, 2 * D, D, nullptr, scr, r, F.lane); continue; } r -= I_SQ;
        if (r < I_SQ) { p0_transpose_item<0>(a.w_out, D, D, a.WO, D, 0, nullptr, scr, r, F.lane); continue; } r -= I_SQ;
        if (r < I_GU) { p0_transpose_item<2>(a.w_fg, D, DFF, a.WGU, D, 0, a.g_ffn, scr, r, F.lane); continue; } r -= I_GU;
        if (r < I_GU) { p0_transpose_item<3>(a.w_fu, D, DFF, a.WGU, D, 0, a.g_ffn, scr, r, F.lane); continue; } r -= I_GU;
        p0_transpose_item<0>(a.w_fd, DFF, D, a.WD, DFF, 0, nullptr, scr, r, F.lane);
    }
    for (int m = gw * 4; m < M; m += NGW * 4) p0_rows<4>(a.x + (size_t)m * D, a.XB + (size_t)m * D, a.rs1 + m, F.lane);
    for (int e = (F.vcu * NWAVES + F.wave) * 64 + F.lane; e < SEQ * 8; e += F.G * NWAVES * 64) rope_entry(e, a.rope);
}

#ifdef PROBE_A
#define CSTAMP(k) do { if (F.tid == 0) F.MISC[12 + (k)] = (unsigned)rt(); } while (0)
#else
#define CSTAMP(k) do { } while (0)
#endif
struct ConvArgs { const bf16* U; bf16* CA; const float *wdw, *bdw, *gln, *bln; };
typedef float f32x2 __attribute__((ext_vector_type(2)));
__device__ __forceinline__ void fmac_(float& a, float w, float u) { asm("v_fmac_f32_e32 %0, %1, %2" : "+v"(a) : "v"(w), "v"(u)); }
template <int I> struct ConvLoop {
    static __device__ __forceinline__ void run(float (&a0)[32], float (&a1)[32], const float (&w0)[31], const float (&w1)[31], const LAS unsigned char* up) {
        const unsigned uv = *(const LAS unsigned*)(up + I * 2048);
        const float u0 = __uint_as_float(uv << 16), u1 = __uint_as_float(uv & 0xffff0000u);
        constexpr int OLO = I > 30 ? I - 30 : 0, OHI = I < 31 ? I : 31;
#pragma unroll
        for (int o = OLO; o <= OHI; ++o) { fmac_(a0[o], w0[I - o], u0); fmac_(a1[o], w1[I - o], u1); }
        if ((I & 3) == 3) __builtin_amdgcn_sched_barrier(0);
        ConvLoop<I + 1>::run(a0, a1, w0, w1, up);
    }
};
template <> struct ConvLoop<62> { static __device__ __forceinline__ void run(float (&)[32], float (&)[32], const float (&)[31], const float (&)[31], const LAS unsigned char*) {} };
constexpr int CONV_TILE_BYTES = 62 * 2048, CONV_RED_OFF = CONV_TILE_BYTES, CONV_STAT_OFF = CONV_RED_OFF + 2048;
static_assert(CONV_STAT_OFF + 256 <= RING_BYTES, "conv LDS map");
__device__ __forceinline__ void conv_dma(Frame& F, const ConvArgs& a, int item) {
    const int row0 = item * 32; const bool head = ((row0 & (SEQ - 1)) == 0);
    const unsigned char* gsrc = (const unsigned char*)(a.U + ((size_t)row0 - 30) * D) + F.lane * 16;
    for (int p = head ? 60 + ((F.wave + 4) & 7) : F.wave; p < 124; p += 8)
        __builtin_amdgcn_global_load_lds((const unsigned*)(gsrc + (size_t)p * 1024), (LAS unsigned*)(F.lds + RING_OFF + p * 1024), 16, 0, 0);
    if (head) for (int q = F.tid; q < 60 * 64; q += NWAVES * 64) *(LAS v4u*)(F.lds + RING_OFF + q * 16) = (v4u){0u, 0u, 0u, 0u};
}
#define CONV_BAR() asm volatile("s_waitcnt lgkmcnt(0)\n\ts_barrier" ::: "memory")
__device__ __forceinline__ void conv_item(Frame& F, const ConvArgs& a, int item, int next_item, const float (&w0)[31], const float (&w1)[31]) {
    const int tid = F.tid, lane = F.lane, c0 = 2 * tid, row0 = item * 32;
    CSTAMP(30);
    float a0[32], a1[32];
#pragma unroll
    for (int o = 0; o < 32; ++o) { a0[o] = 0.f; a1[o] = 0.f; }
    asm volatile("s_waitcnt vmcnt(0) lgkmcnt(0)\n\ts_barrier" ::: "memory");
    CSTAMP(31);
    ConvLoop<0>::run(a0, a1, w0, w1, F.lds + RING_OFF + tid * 4);
    CSTAMP(32);
    const f32x2 bd = *(const f32x2*)(a.bdw + c0);
    LAS float* red = (LAS float*)(F.lds + RING_OFF + CONV_RED_OFF);
    LAS float* stat = (LAS float*)(F.lds + RING_OFF + CONV_STAT_OFF);
#define TR_STEP(OFF, N) { const bool up_ = (lane & (OFF)) != 0; _Pragma("unroll") for (int k = 0; k < (N); ++k) { const float send = up_ ? v[k] : v[k + (N)], keep = up_ ? v[k + (N)] : v[k]; v[k] = keep + __shfl_xor(send, (OFF)); } }
#pragma unroll
    for (int pass = 0; pass < 2; ++pass) {
        float v[32];
#pragma unroll
        for (int o = 0; o < 32; ++o) { if (pass == 0) { a0[o] += bd.x; a1[o] += bd.y; v[o] = a0[o] + a1[o]; } else v[o] = a0[o] * a0[o] + a1[o] * a1[o]; }
        TR_STEP(32, 16) TR_STEP(16, 8) TR_STEP(8, 4) TR_STEP(4, 2) TR_STEP(2, 1)
        v[0] += __shfl_xor(v[0], 1);
        if ((lane & 1) == 0) red[F.wave * 64 + pass * 32 + (lane >> 1)] = v[0];
    }
#undef TR_STEP
    CONV_BAR();
    if (next_item >= 0) conv_dma(F, a, next_item);
    if (tid < 32) { float s = 0.f, q = 0.f;
#pragma unroll
        for (int wv = 0; wv < 8; ++wv) { s += red[wv * 64 + tid]; q += red[wv * 64 + 32 + tid]; }
        const float mean = s * (1.f / D), var = q * (1.f / D) - mean * mean;
        stat[tid] = mean; stat[32 + tid] = 1.f / sqrtf(fmaxf(var, 0.f) + LN_EPS); }
    CONV_BAR();
    CSTAMP(33);
    const f32x2 gl = *(const f32x2*)(a.gln + c0), bl = *(const f32x2*)(a.bln + c0);
    bf16* op = a.CA + (size_t)row0 * 2048 + c0;
#pragma unroll
    for (int o = 0; o < 32; ++o) { const float mean = stat[o], rstd = stat[32 + o];
        const float y0 = (a0[o] - mean) * rstd * gl.x + bl.x, y1 = (a1[o] - mean) * rstd * gl.y + bl.y;
        *(unsigned*)op = pg8::cvt_pk_bf16(y0 * pg8::sigm(y0), y1 * pg8::sigm(y1));
        op += 2048; asm volatile("" : "+v"(op)); }
    CONV_BAR();
    CSTAMP(34);
}
#undef CONV_BAR

namespace att {
typedef short bf16x8 __attribute__((ext_vector_type(8)));
typedef short s16x4 __attribute__((ext_vector_type(4)));
typedef float f32x16 __attribute__((ext_vector_type(16)));
typedef short v4i16_t __attribute__((ext_vector_type(4)));
__device__ __forceinline__ int crow(int r, int hi) { return (r & 3) + 8 * (r >> 2) + 4 * hi; }
__device__ __forceinline__ s16x4 vtr(const LAS unsigned char* p) { return __builtin_bit_cast(s16x4, __builtin_amdgcn_ds_read_tr16_b64_v4i16((LAS v4i16_t*)p)); }
#define ATT_MFMA(a, b, c) __builtin_amdgcn_mfma_f32_32x32x16_bf16(a, b, c, 0, 0, 0)
__device__ __forceinline__ void attn_unit(int b, int h, int qb, bf16* CA, const bf16* Kp, const bf16* Vp, const float* gsub, float lam, LAS unsigned char* lds) {
    const int tid = threadIdx.x, lane = tid & 63, r32 = lane & 31, hi = lane >> 5;
    const int wid = __builtin_amdgcn_readfirstlane(tid >> 6), comp = wid >> 2, w4 = wid & 3;
    const int q0 = qb * 128, NT = 2 * qb + 2;
    const size_t rowbase = (size_t)b * SEQ;
    LAS float* wsf = (LAS float*)(lds + 65536) + wid * 32;
    const bf16* Qp = CA + (rowbase + q0 + w4 * 32 + r32) * 2048 + 1024 + h * 128 + comp * 64 + hi * 8;
    bf16x8 qr[4];
#pragma unroll
    for (int d0 = 0; d0 < 4; ++d0) qr[d0] = *(const bf16x8*)(Qp + d0 * 16);
    const unsigned char* Kt = (const unsigned char*)(Kp + (size_t)((b * 8 + h) * 32) * 8192) + tid * 16;
    const unsigned char* Vt = (const unsigned char*)(Vp + (size_t)((b * 8 + h) * 32) * 8192) + tid * 16;
    v4u ks0 = *(const v4u*)(Kt), ks1 = *(const v4u*)(Kt + 8192), vs0 = *(const v4u*)(Vt), vs1 = *(const v4u*)(Vt + 8192);
    { LAS unsigned char* d = lds + tid * 16; *(LAS v4u*)(d) = ks0; *(LAS v4u*)(d + 8192) = ks1; *(LAS v4u*)(d + 16384) = vs0; *(LAS v4u*)(d + 24576) = vs1; }
    __syncthreads();
    f32x16 o[4];
#pragma unroll
    for (int d = 0; d < 4; ++d)
#pragma unroll
        for (int r = 0; r < 16; ++r) o[d][r] = 0.f;
    float mref = -1e30f, l = 0.f;
    const int qrel = w4 * 32 + r32;
    for (int t = 0; t < NT; ++t) {
        const int buf = t & 1; const bool more = (t + 1 < NT);
        if (more) { const size_t go = (size_t)(t + 1) * 16384; ks0 = *(const v4u*)(Kt + go); ks1 = *(const v4u*)(Kt + go + 8192); vs0 = *(const v4u*)(Vt + go); vs1 = *(const v4u*)(Vt + go + 8192); }
        const int jb = t - (NT - 2);
        const bool skip = (jb == 1) && (w4 < 2);
        if (!skip) {
            const LAS unsigned char* kb = lds + buf * 32768 + comp * 8192 + hi * 1024 + r32 * 16;
            f32x16 p0, p1;
#pragma unroll
            for (int r = 0; r < 16; ++r) { p0[r] = 0.f; p1[r] = 0.f; }
#pragma unroll
            for (int d0 = 0; d0 < 4; ++d0) { const bf16x8 a0 = *(const LAS bf16x8*)(kb + d0 * 2048), a1 = *(const LAS bf16x8*)(kb + d0 * 2048 + 512);
                p0 = ATT_MFMA(a0, qr[d0], p0); p1 = ATT_MFMA(a1, qr[d0], p1); }
            if (jb >= 0) { const int kb_ = 64 * jb + 4 * hi;
#pragma unroll
                for (int r = 0; r < 16; ++r) { const int kv = kb_ + (r & 3) + 8 * (r >> 2); if (kv > qrel) p0[r] = -INFINITY; if (kv + 32 > qrel) p1[r] = -INFINITY; } }
            float rm = fmaxf(p0[0], p1[0]);
#pragma unroll
            for (int r = 1; r < 16; ++r) rm = fmaxf(rm, fmaxf(p0[r], p1[r]));
            rm = fmaxf(rm, __shfl_xor(rm, 32));
            if (__any(rm > mref + 8.f)) {
                const float mnew = fmaxf(mref, rm), f = pg8::ex2(mref - mnew); mref = mnew; l *= f;
                if (hi == 0) wsf[r32] = f;
#pragma unroll
                for (int r = 0; r < 16; ++r) { const float fr_ = wsf[crow(r, hi)];
#pragma unroll
                    for (int d = 0; d < 4; ++d) o[d][r] *= fr_; }
            }
            float sacc = 0.f;
#pragma unroll
            for (int r = 0; r < 16; ++r) { p0[r] = pg8::ex2(p0[r] - mref); p1[r] = pg8::ex2(p1[r] - mref); sacc += p0[r] + p1[r]; }
            l += sacc;
            v4u pw[4];
#pragma unroll
            for (int k = 0; k < 2; ++k) {
                pw[k] = (v4u){pg8::cvt_pk_bf16(p0[8 * k], p0[8 * k + 1]), pg8::cvt_pk_bf16(p0[8 * k + 2], p0[8 * k + 3]), pg8::cvt_pk_bf16(p0[8 * k + 4], p0[8 * k + 5]), pg8::cvt_pk_bf16(p0[8 * k + 6], p0[8 * k + 7])};
                pw[2 + k] = (v4u){pg8::cvt_pk_bf16(p1[8 * k], p1[8 * k + 1]), pg8::cvt_pk_bf16(p1[8 * k + 2], p1[8 * k + 3]), pg8::cvt_pk_bf16(p1[8 * k + 4], p1[8 * k + 5]), pg8::cvt_pk_bf16(p1[8 * k + 6], p1[8 * k + 7])}; }
            const LAS unsigned char* vb = lds + buf * 32768 + 16384 + (4 * hi + ((lane & 15) >> 2)) * 64 + ((lane >> 4) & 1) * 32 + (lane & 3) * 8;
#pragma unroll
            for (int d = 0; d < 4; ++d)
#pragma unroll
                for (int k = 0; k < 4; ++k) { const s16x4 lo = vtr(vb + (d * 4 + k) * 1024), hh = vtr(vb + (d * 4 + k) * 1024 + 512);
                    const bf16x8 vf = {lo[0], lo[1], lo[2], lo[3], hh[0], hh[1], hh[2], hh[3]};
                    o[d] = ATT_MFMA(__builtin_bit_cast(bf16x8, pw[k]), vf, o[d]); }
        }
        if (more) { LAS unsigned char* d = lds + (buf ^ 1) * 32768 + tid * 16; *(LAS v4u*)(d) = ks0; *(LAS v4u*)(d + 8192) = ks1; *(LAS v4u*)(d + 16384) = vs0; *(LAS v4u*)(d + 24576) = vs1; }
        __syncthreads();
    }
    l += __shfl_xor(l, 32);
    { float inv = 1.f / l; if (comp == 1) inv *= lam; if (hi == 0) wsf[r32] = inv; }
#pragma unroll
    for (int r = 0; r < 16; ++r) { const float ri = wsf[crow(r, hi)];
#pragma unroll
        for (int d = 0; d < 4; ++d) o[d][r] *= ri; }
    LAS f32x4* X = (LAS f32x4*)lds;
    if (comp == 1) {
#pragma unroll
        for (int d = 0; d < 4; ++d)
#pragma unroll
            for (int rq = 0; rq < 4; ++rq) X[((w4 * 4 + d) * 4 + rq) * 64 + lane] = (f32x4){o[d][4 * rq], o[d][4 * rq + 1], o[d][4 * rq + 2], o[d][4 * rq + 3]};
    }
    __syncthreads();
    if (comp == 0) {
        float ss[16];
#pragma unroll
        for (int r = 0; r < 16; ++r) ss[r] = 0.f;
#pragma unroll
        for (int d = 0; d < 4; ++d)
#pragma unroll
            for (int rq = 0; rq < 4; ++rq) { const f32x4 x = X[((w4 * 4 + d) * 4 + rq) * 64 + lane];
#pragma unroll
                for (int e = 0; e < 4; ++e) { const float y = o[d][4 * rq + e] - x[e]; o[d][4 * rq + e] = y; ss[4 * rq + e] += y * y; } }
#pragma unroll
        for (int r = 0; r < 16; ++r) {
#pragma unroll
            for (int off = 1; off < 32; off <<= 1) ss[r] += __shfl_xor(ss[r], off);
            ss[r] = 1.f / sqrtf(ss[r] * (1.f / 128.f) + RMS_EPS); }
        float gs[4];
#pragma unroll
        for (int d = 0; d < 4; ++d) gs[d] = gsub[32 * d + r32] * 0.8f;
        bf16* Op = CA + (rowbase + q0 + w4 * 32) * 2048 + 1024 + h * 128 + r32;
#pragma unroll
        for (int r = 0; r < 16; ++r) { bf16* rp = Op + (size_t)crow(r, hi) * 2048;
#pragma unroll
            for (int d = 0; d < 4; ++d) rp[32 * d] = (bf16)f2bf(o[d][r] * ss[r] * gs[d]); }
    }
    __syncthreads();
}
#undef ATT_MFMA
}

namespace att2 {
#ifdef PROBE_A
#define ASTAMP(k) do { if (threadIdx.x == 0 && qb == PROBE_QB && comp == PROBE_COMP) ((volatile unsigned*)(shm + MISC_OFF))[12 + (k)] = (unsigned)__builtin_amdgcn_s_memrealtime(); } while (0)
#else
#define ASTAMP(k) do { } while (0)
#endif
typedef short bf16x8 __attribute__((ext_vector_type(8)));
typedef short s16x4 __attribute__((ext_vector_type(4)));
typedef float f32x16 __attribute__((ext_vector_type(16)));
typedef short v4i16_t __attribute__((ext_vector_type(4)));
typedef __attribute__((address_space(3))) const char* lds_cptr;
constexpr int NW = 8, QBLK = 32, QB = 256, KVBLK = 64;
constexpr int KSLOT = 8192, VSLOT = 16384, NSLOT = 3;
constexpr int LDS_K = 0, LDS_V = NSLOT * KSLOT, LDS_WS = LDS_V + NSLOT * VSLOT, LDS_OST = LDS_WS + NW * 64 * 4, LDS_END = LDS_OST + NW * 8192;
__device__ __forceinline__ int crow(int r, int hi) { return (r & 3) + 8 * (r >> 2) + 4 * hi; }
#define SBAR() __builtin_amdgcn_sched_barrier(0)
#define PIN(x) asm volatile("" : "+v"(x))
#define MFMA(a, b, c) __builtin_amdgcn_mfma_f32_32x32x16_bf16(a, b, c, 0, 0, 0)
#define WAIT_BAR(N) asm volatile("s_waitcnt vmcnt(" #N ") lgkmcnt(0)\n\ts_barrier" ::: "memory")
#define MX3(a, b, c) __builtin_fmaxf(__builtin_fmaxf((a), (b)), (c))
__device__ __forceinline__ void glds16(const void* g, unsigned lds_base) {
    unsigned sv; asm volatile("s_mov_b32 %0, m0\n\ts_mov_b32 m0, %2\n\ts_nop 0\n\tglobal_load_lds_dwordx4 %1, off\n\ts_mov_b32 m0, %0" : "=&s"(sv) : "v"(g), "s"(lds_base) : "memory"); }
__device__ __forceinline__ void kload2(bf16x8* kf, lds_cptr kp, int d0) { kf[2 * d0] = *(const __attribute__((address_space(3))) bf16x8*)(kp + d0 * 2048); kf[2 * d0 + 1] = *(const __attribute__((address_space(3))) bf16x8*)(kp + d0 * 2048 + 512); }
__device__ __forceinline__ s16x4 vtr(lds_cptr p) { return __builtin_bit_cast(s16x4, __builtin_amdgcn_ds_read_tr16_b64_v4i16((__attribute__((address_space(3))) v4i16_t*)p)); }
__device__ __forceinline__ unsigned cvtpk(float lo, float hi) { typedef float f2 __attribute__((ext_vector_type(2))); typedef __bf16 b2 __attribute__((ext_vector_type(2))); f2 v = {lo, hi}; b2 b = __builtin_convertvector(v, b2); return __builtin_bit_cast(unsigned, b); }
__device__ __forceinline__ float rowmax(const f32x16& p0, const f32x16& p1) {
    float a = MX3(p0[0], p0[1], p1[0]), b = MX3(p0[2], p0[3], p1[1]); a = MX3(a, p1[2], p1[3]);
#pragma unroll
    for (int r = 4; r < 16; r += 4) { a = MX3(a, p0[r], p0[r + 1]); b = MX3(b, p0[r + 2], p0[r + 3]); a = MX3(a, p1[r], p1[r + 1]); b = MX3(b, p1[r + 2], p1[r + 3]); }
    float m = __builtin_fmaxf(a, b); auto rr = __builtin_amdgcn_permlane32_swap(__float_as_uint(m), __float_as_uint(m), false, false);
    return __builtin_fmaxf(__uint_as_float(rr[0]), __uint_as_float(rr[1])); }
__device__ __forceinline__ void cmask(f32x16& p0, f32x16& p1, int jb, int qrel, int hi) {
    const int kb = 64 * jb + 4 * hi;
#pragma unroll
    for (int r = 0; r < 16; ++r) { const int kv = kb + (r & 3) + 8 * (r >> 2); if (kv > qrel) p0[r] = -INFINITY; if (kv + 32 > qrel) p1[r] = -INFINITY; } }

struct UnitP { int b, h, comp, qb; };
#define DMA_K(t, slot) glds16(ksrc + (long)(t) * 16384, (unsigned)__builtin_amdgcn_readfirstlane(kdst + (slot)))
#define DMA_V(t, slot) do { glds16(vsrc + (long)(t) * 16384, (unsigned)__builtin_amdgcn_readfirstlane(vdst + 2 * (slot))); glds16(vsrc + (long)(t) * 16384 + 8192, (unsigned)__builtin_amdgcn_readfirstlane(vdst + 2 * (slot) + 8192)); } while (0)
#define ATT_SRC(u) \
    const char* ksrc = (const char*)(Kp + (size_t)(((u).b * 8 + (u).h) * 32) * 8192) + (u).comp * 8192 + wid * 1024 + lane * 16; \
    const char* vsrc = (const char*)(Vp + (size_t)(((u).b * 8 + (u).h) * 32) * 8192) + wid * 1024 + lane * 16; \
    const unsigned kdst = lds0 + LDS_K + wid * 1024, vdst = lds0 + LDS_V + wid * 1024;
__device__ __forceinline__ void attn_issue(const UnitP u, const bf16* __restrict__ Kp, const bf16* __restrict__ Vp, char* shm) {
    int tid = threadIdx.x; asm volatile("" : "+v"(tid));
    const int lane = tid & 63; const int wid = __builtin_amdgcn_readfirstlane(tid >> 6); const unsigned lds0 = (unsigned)(uintptr_t)shm;
    ATT_SRC(u)
    DMA_K(0, 0); DMA_V(0, 0); DMA_K(1, KSLOT); DMA_K(2, 2 * KSLOT);
}
__device__ __forceinline__ void attn_loadq(const UnitP u, const bf16* CA, bf16x8 (&qr)[4]) {
    int tid = threadIdx.x; asm volatile("" : "+v"(tid));
    const int lane = tid & 63, r32 = lane & 31, hi = lane >> 5; const int wid = __builtin_amdgcn_readfirstlane(tid >> 6);
    const bf16* Qw = CA + ((long)u.b * SEQ + u.qb * QB + wid * QBLK + r32) * 2048 + 1024 + u.h * 128 + u.comp * 64 + hi * 8;
#pragma unroll
    for (int d0 = 0; d0 < 4; ++d0) qr[d0] = *reinterpret_cast<const bf16x8*>(Qw + d0 * 16);
}
template <int THRL> __device__ __forceinline__ void attn_unit(const UnitP u, const UnitP nu, bool has_next, bf16x8 (&qr)[4], bf16* CA, const bf16* __restrict__ Kp, const bf16* __restrict__ Vp, float* Osc, const float* gsub, float lam, char* shm) {
    int tid = threadIdx.x; asm volatile("" : "+v"(tid));
    const int lane = tid & 63, r32 = lane & 31, hi = lane >> 5; const int wid = __builtin_amdgcn_readfirstlane(tid >> 6);
    const int b = u.b, h = u.h, comp = u.comp, qb = u.qb;
    const long rowbase = (long)b * SEQ; const int q0 = qb * QB, NT = (q0 + QB) / KVBLK;
    const unsigned lds0 = (unsigned)(uintptr_t)shm; float* wsf = (float*)(shm + LDS_WS) + wid * 64;
    ATT_SRC(u)
    const lds_cptr vp0 = (lds_cptr)shm + LDS_V + ((lane >> 4) & 1) * 32 + (lane & 3) * 8 + (4 * hi + ((lane & 15) >> 2)) * 64;
    const lds_cptr kp0 = (lds_cptr)shm + LDS_K + hi * 1024 + r32 * 16;
    ASTAMP(40);
    float mhat = 0.f, l_reg = 0.f; f32x16 o[4];
#pragma unroll
    for (int d = 0; d < 4; ++d) o[d] = f32x16{};
    const int qrel = wid * QBLK + r32; bool resc = false;
    f32x16 c0, c1; bf16x8 kf[8]; s16x4 vlo[4], vhi[4]; v4u pwa[4], pwb[4]; const f32x16 zero16 = f32x16{};
    f32x16 negm = f32x16{}; PIN(negm);
    int sl_prev = 0, sl_cur = 0, sl_next = KSLOT;
#define ROT() do { sl_prev = sl_cur; sl_cur = sl_next; sl_next = (sl_next == 2 * KSLOT) ? 0 : sl_next + KSLOT; } while (0)
#define RESC() do { if (resc) { _Pragma("unroll") for (int r = 0; r < 16; ++r) { const float f_ = wsf[crow(r, hi)]; _Pragma("unroll") for (int d_ = 0; d_ < 4; ++d_) o[d_][r] *= f_; } } } while (0)
#define CMASK(t) do { const int jb_ = (t) - (NT - 4); if (jb_ >= 0) cmask(c0, c1, jb_, qrel, hi); } while (0)
#define VRD(i, f) do { vlo[i] = vtr(vp_ + (f) * 1024); vhi[i] = vtr(vp_ + (f) * 1024 + 512); } while (0)
#define VFR(i) (bf16x8){vlo[i][0], vlo[i][1], vlo[i][2], vlo[i][3], vhi[i][0], vhi[i][1], vhi[i][2], vhi[i][3]}
#define PAF(P, k) __builtin_bit_cast(bf16x8, P[k])
#define EX(v) __builtin_amdgcn_exp2f(v)
    WAIT_BAR(4);
#pragma unroll
    for (int d0 = 0; d0 < 4; ++d0) kload2(kf, kp0, d0);
    c0 = MFMA(kf[0], qr[0], zero16); c1 = MFMA(kf[1], qr[0], zero16); c0 = MFMA(kf[2], qr[1], c0); c1 = MFMA(kf[3], qr[1], c1);
    c0 = MFMA(kf[4], qr[2], c0); c1 = MFMA(kf[5], qr[2], c1); c0 = MFMA(kf[6], qr[3], c0); c1 = MFMA(kf[7], qr[3], c1);
    CMASK(0);
    { const float rm = rowmax(c0, c1); mhat = rm; float sacc = 0.f;
#pragma unroll
      for (int r = 0; r < 16; ++r) negm[r] = -mhat;
      PIN(negm);
#pragma unroll
      for (int r = 0; r < 16; ++r) { c0[r] = EX(c0[r] - rm); c1[r] = EX(c1[r] - rm); sacc += c0[r] + c1[r]; }
      l_reg = sacc;
#pragma unroll
      for (int k = 0; k < 2; ++k) { pwa[k] = (v4u){cvtpk(c0[8 * k], c0[8 * k + 1]), cvtpk(c0[8 * k + 2], c0[8 * k + 3]), cvtpk(c0[8 * k + 4], c0[8 * k + 5]), cvtpk(c0[8 * k + 6], c0[8 * k + 7])};
                                    pwa[2 + k] = (v4u){cvtpk(c1[8 * k], c1[8 * k + 1]), cvtpk(c1[8 * k + 2], c1[8 * k + 3]), cvtpk(c1[8 * k + 4], c1[8 * k + 5]), cvtpk(c1[8 * k + 6], c1[8 * k + 7])}; } }
    WAIT_BAR(0);
    DMA_K(3, 0); DMA_V(1, KSLOT);
    ROT();
#pragma unroll
    for (int d0 = 0; d0 < 4; ++d0) kload2(kf, kp0 + sl_cur, d0);
    WAIT_BAR(3);
#define GA(MF) do { MF; SBAR(); } while (0)
#define GAV(i, f, MF) do { VRD(i, f); SBAR(); MF; SBAR(); } while (0)
#define GB(PC, w, j, C, B, MF) do { MF; C[B] = EX(C[B]); C[B + 1] = EX(C[B + 1]); sacc += C[B]; sacc += C[B + 1]; PC[w][j] = cvtpk(C[B], C[B + 1]); PIN(sacc); PIN(PC[w]); SBAR(); } while (0)
#define KRD(G, j) do { if (G) { kload2(kf, kp0 + sl_next, j); SBAR(); } } while (0)
#define STEP(PP, PC, t, GK, GV, GL) do { SBAR(); \
    const lds_cptr vp_ = vp0 + 2 * sl_prev; \
    GA(c0 = MFMA(kf[0], qr[0], negm)); GA(c1 = MFMA(kf[1], qr[0], negm)); GA(c0 = MFMA(kf[2], qr[1], c0)); GA(c1 = MFMA(kf[3], qr[1], c1)); \
    GAV(0, 0, c0 = MFMA(kf[4], qr[2], c0)); GAV(1, 1, c1 = MFMA(kf[5], qr[2], c1)); GAV(2, 2, c0 = MFMA(kf[6], qr[3], c0)); GAV(3, 3, c1 = MFMA(kf[7], qr[3], c1)); \
    if (GK) { DMA_K((t) + 3, sl_cur); } if (GV) { DMA_V((t) + 1, sl_next); } \
    CMASK(t); \
    { const float rm = rowmax(c0, c1); resc = false; \
      if (__builtin_expect(__any(rm > (float)THRL), 0)) { const float dl = __builtin_fmaxf(rm, 0.f); mhat += dl; \
        _Pragma("unroll") for (int r = 0; r < 16; ++r) { c0[r] -= dl; c1[r] -= dl; } \
        _Pragma("unroll") for (int r = 0; r < 16; ++r) negm[r] = -mhat; PIN(negm); \
        const float f = __builtin_amdgcn_exp2f(-dl); l_reg *= f; if (hi == 0) wsf[r32] = f; resc = true; } } \
    SBAR(); float sacc = 0.f; \
    GB(PC, 0, 0, c0, 0,  o[0] = MFMA(PAF(PP, 0), VFR(0), o[0])); VRD(0, 4);  SBAR(); \
    GB(PC, 0, 1, c0, 2,  o[0] = MFMA(PAF(PP, 1), VFR(1), o[0])); VRD(1, 5);  SBAR(); \
    GB(PC, 0, 2, c0, 4,  o[0] = MFMA(PAF(PP, 2), VFR(2), o[0])); VRD(2, 6);  SBAR(); \
    GB(PC, 0, 3, c0, 6,  o[0] = MFMA(PAF(PP, 3), VFR(3), o[0])); VRD(3, 7);  SBAR(); \
    GB(PC, 1, 0, c0, 8,  o[1] = MFMA(PAF(PP, 0), VFR(0), o[1])); VRD(0, 8);  SBAR(); \
    GB(PC, 1, 1, c0, 10, o[1] = MFMA(PAF(PP, 1), VFR(1), o[1])); VRD(1, 9);  SBAR(); \
    GB(PC, 1, 2, c0, 12, o[1] = MFMA(PAF(PP, 2), VFR(2), o[1])); VRD(2, 10); SBAR(); \
    GB(PC, 1, 3, c0, 14, o[1] = MFMA(PAF(PP, 3), VFR(3), o[1])); VRD(3, 11); SBAR(); \
    GB(PC, 2, 0, c1, 0,  o[2] = MFMA(PAF(PP, 0), VFR(0), o[2])); VRD(0, 12); SBAR(); \
    GB(PC, 2, 1, c1, 2,  o[2] = MFMA(PAF(PP, 1), VFR(1), o[2])); VRD(1, 13); SBAR(); \
    GB(PC, 2, 2, c1, 4,  o[2] = MFMA(PAF(PP, 2), VFR(2), o[2])); VRD(2, 14); SBAR(); \
    GB(PC, 2, 3, c1, 6,  o[2] = MFMA(PAF(PP, 3), VFR(3), o[2])); VRD(3, 15); SBAR(); \
    GB(PC, 3, 0, c1, 8,  o[3] = MFMA(PAF(PP, 0), VFR(0), o[3])); KRD(GL, 0); \
    GB(PC, 3, 1, c1, 10, o[3] = MFMA(PAF(PP, 1), VFR(1), o[3])); KRD(GL, 1); \
    GB(PC, 3, 2, c1, 12, o[3] = MFMA(PAF(PP, 2), VFR(2), o[3])); KRD(GL, 2); \
    GB(PC, 3, 3, c1, 14, o[3] = MFMA(PAF(PP, 3), VFR(3), o[3])); KRD(GL, 3); \
    l_reg += sacc; \
  } while (0)
    ASTAMP(41);
    int t = 1;
#undef CMASK
#define CMASK(t) do { } while (0)
    for (; t + 5 < NT; t += 2) {
        STEP(pwa, pwb, t, true, true, true);     WAIT_BAR(3); RESC(); ROT();
        STEP(pwb, pwa, t + 1, true, true, true); WAIT_BAR(3); RESC(); ROT();
    }
#undef CMASK
#define CMASK(t) do { const int jb_ = (t) - (NT - 4); if (jb_ >= 0) cmask(c0, c1, jb_, qrel, hi); } while (0)
#define ENDW(tt) do { if ((tt) + 3 < NT) { WAIT_BAR(3); } else if ((tt) + 2 < NT) { WAIT_BAR(2); } else { WAIT_BAR(0); } } while (0)
    for (; t + 1 < NT; t += 2) {
        STEP(pwa, pwb, t, (t + 3 < NT), (t + 1 < NT), (t + 1 < NT));         ENDW(t);     RESC(); ROT();
        STEP(pwb, pwa, t + 1, (t + 4 < NT), (t + 2 < NT), (t + 2 < NT));     ENDW(t + 1); RESC(); ROT();
    }
    STEP(pwa, pwb, NT - 1, false, false, false); RESC();
    { const lds_cptr vp_ = vp0 + 2 * sl_cur; SBAR();
#pragma unroll
      for (int d = 0; d < 4; ++d) {
#pragma unroll
          for (int k = 0; k < 4; ++k) VRD(k, d * 4 + k);
#pragma unroll
          for (int k = 0; k < 4; ++k) o[d] = MFMA(PAF(pwb, k), VFR(k), o[d]); } }
    asm volatile("s_waitcnt lgkmcnt(0)\n\ts_barrier" ::: "memory");
    if (has_next) { attn_issue(nu, Kp, Vp, shm); attn_loadq(nu, CA, qr); }
    ASTAMP(42);
    { auto rr = __builtin_amdgcn_permlane32_swap(__float_as_uint(l_reg), __float_as_uint(l_reg), false, false); l_reg = __uint_as_float(rr[0]) + __uint_as_float(rr[1]); }
    if (hi == 0) wsf[32 + r32] = l_reg;
    asm volatile("s_waitcnt lgkmcnt(0)" ::: "memory");
    const float osc = comp ? lam : 1.f;
    int lane_ = lane, wid_ = wid; asm volatile("" : "+v"(lane_), "+s"(wid_));
    const int r32_ = lane_ & 31, hi_ = lane_ >> 5;
#pragma unroll
    for (int r = 0; r < 16; ++r) { const float ri = __builtin_amdgcn_rcpf(wsf[32 + crow(r, hi)]) * osc;
#pragma unroll
        for (int d = 0; d < 4; ++d) o[d][r] *= ri; }
    f32x4* Ow = (f32x4*)Osc + (size_t)wid_ * 1024 + lane_;
    if (comp == 0) {
#pragma unroll
        for (int d = 0; d < 4; ++d)
#pragma unroll
            for (int rq = 0; rq < 4; ++rq) Ow[(d * 4 + rq) * 64] = (f32x4){o[d][4 * rq], o[d][4 * rq + 1], o[d][4 * rq + 2], o[d][4 * rq + 3]};
    } else {
        float ss[16];
#pragma unroll
        for (int r = 0; r < 16; ++r) ss[r] = 0.f;
#pragma unroll
        for (int d = 0; d < 4; ++d)
#pragma unroll
            for (int rq = 0; rq < 4; ++rq) { const f32x4 x = __builtin_nontemporal_load(Ow + (d * 4 + rq) * 64);
#pragma unroll
                for (int e = 0; e < 4; ++e) { const float y = x[e] - o[d][4 * rq + e]; o[d][4 * rq + e] = y; ss[4 * rq + e] += y * y; } }
#define TR_STEP(OFF, N) { const bool up_ = (lane_ & (OFF)) != 0; _Pragma("unroll") for (int k = 0; k < (N); ++k) { const float send = up_ ? ss[k] : ss[k + (N)], keep = up_ ? ss[k + (N)] : ss[k]; ss[k] = keep + __shfl_xor(send, (OFF)); } }
        TR_STEP(16, 8) TR_STEP(8, 4) TR_STEP(4, 2) TR_STEP(2, 1)
#undef TR_STEP
        ss[0] += __shfl_xor(ss[0], 1);
        if ((lane_ & 1) == 0) wsf[hi_ * 16 + ((lane_ >> 1) & 15)] = __builtin_amdgcn_rsqf(ss[0] * (1.f / 128.f) + RMS_EPS);
        asm volatile("s_waitcnt lgkmcnt(0)" ::: "memory");
#pragma unroll
        for (int r = 0; r < 16; ++r) ss[r] = wsf[hi_ * 16 + r];
        float gs[4];
#pragma unroll
        for (int d = 0; d < 4; ++d) gs[d] = gsub[32 * d + r32_] * 0.8f;
        bf16* stg = (bf16*)(shm + LDS_OST) + wid_ * 4096;
#pragma unroll
        for (int r = 0; r < 16; ++r) { bf16* sp = stg + crow(r, hi_) * 128 + r32_;
#pragma unroll
            for (int d = 0; d < 4; ++d) sp[32 * d] = (bf16)cvtpk(o[d][r] * ss[r] * gs[d], 0.f); }
        asm volatile("s_waitcnt lgkmcnt(0)" ::: "memory");
        bf16* Op = CA + (rowbase + q0 + wid_ * QBLK) * 2048 + 1024 + h * 128;
#pragma unroll
        for (int i = 0; i < 8; ++i) { const int row = i * 4 + (lane_ >> 4), ch = lane_ & 15; const v4u v = *(const v4u*)(stg + row * 128 + ch * 8); *(v4u*)(Op + (size_t)row * 2048 + ch * 8) = v; }
    }
    asm volatile("s_waitcnt lgkmcnt(0)" ::: "memory");
    ASTAMP(43);
#undef ROT
#undef RESC
#undef CMASK
#undef VRD
#undef VFR
#undef PAF
#undef EX
#undef GA
#undef GAV
#undef GB
#undef KRD
#undef STEP
#undef ENDW
}
#undef DMA_K
#undef DMA_V
#undef ATT_SRC
#undef SBAR
#undef PIN
#undef MFMA
#undef WAIT_BAR
#undef MX3
}

__device__ __forceinline__ void final_rows(Frame& F, float* out, const float* part, const float* gfin) {
    const int gw = F.vcu * NWAVES + F.wave, NGW = F.G * NWAVES;
    f32x4 g[4];
#pragma unroll
    for (int j = 0; j < 4; ++j) g[j] = *((const GAS f32x4*)gfin + F.lane + 64 * j);
    for (int m = gw; m < M; m += NGW) {
        GAS f32x4* xr = (GAS f32x4*)(out + (size_t)m * D) + F.lane;
        f32x4 v[4];
#pragma unroll
        for (int j = 0; j < 4; ++j) v[j] = xr[64 * j];
        const f32x4 p0 = *(const f32x4*)(part + (size_t)m * 16), p1 = *(const f32x4*)(part + (size_t)m * 16 + 4), p2 = *(const f32x4*)(part + (size_t)m * 16 + 8), p3 = *(const f32x4*)(part + (size_t)m * 16 + 12);
        const float s = (((p0[0] + p0[1]) + (p0[2] + p0[3])) + ((p1[0] + p1[1]) + (p1[2] + p1[3]))) + (((p2[0] + p2[1]) + (p2[2] + p2[3])) + ((p3[0] + p3[1]) + (p3[2] + p3[3])));
        const float rs = 1.f / sqrtf(s * (1.f / D) + RMS_EPS);
#pragma unroll
        for (int j = 0; j < 4; ++j) xr[64 * j] = v[j] * rs * g[j];
    }
}

struct Args { const float* in[21]; float* out; unsigned char* ws; int ph_lo, ph_hi, li, pad; };
__global__ void __launch_bounds__(NWAVES * 64, 2) hyb_fwd(Args args) {
    extern __shared__ __attribute__((aligned(16))) unsigned char lds[];
    Frame F;
    F.lds = (LAS unsigned char*)lds;
    F.MISC = (volatile LAS unsigned*)(F.lds + MISC_OFF);
    F.tid = threadIdx.x; F.lane = F.tid & 63; F.wave = __builtin_amdgcn_readfirstlane(F.tid >> 6);
    F.G = gridDim.x; { const int bx = blockIdx.x; F.vcu = (F.G % 8 == 0) ? (bx % 8) * (F.G / 8) + bx / 8 : bx; }
    unsigned char* ws = args.ws;
    F.ctl = (gu32*)(ws + WS_CTL);
#define IN_(k) (args.in[k])
#define x_ IN_(0)
#define g_mix IN_(1)
#define w_in IN_(2)
#define b_gate IN_(3)
#define w_dw IN_(4)
#define b_dw IN_(5)
#define g_cln IN_(6)
#define b_cln IN_(7)
#define w_cpw IN_(8)
#define lq1 IN_(9)
#define lk1 IN_(10)
#define lq2 IN_(11)
#define lk2 IN_(12)
#define g_sub IN_(13)
#define w_apw IN_(14)
#define w_out IN_(15)
#define g_ffn IN_(16)
#define w_fg IN_(17)
#define w_fu IN_(18)
#define w_fd IN_(19)
#define g_fin IN_(20)
#define out (args.out)
#define WIN ((bf16*)(ws + WS_WIN))
#define WCA ((bf16*)(ws + WS_WCA))
#define WO ((bf16*)(ws + WS_WO))
#define WGU ((bf16*)(ws + WS_WGU))
#define WD ((bf16*)(ws + WS_WD))
#define ROPE ((float*)(ws + WS_ROPE))
#define RS1 ((float*)(ws + WS_RS1))
#define PART1 ((float*)(ws + WS_PART1))
#define PART2 ((float*)(ws + WS_PART2))
#define XB ((bf16*)(ws + WS_XB))
#define U ((bf16*)(ws + WS_U))
#define CA ((bf16*)(ws + WS_CA))
#define VP ((bf16*)(ws + WS_V))
#define KP ((bf16*)(ws + WS_K))
#define MERGED ((bf16*)(ws + WS_MERGED))
#define X1B ((bf16*)(ws + WS_X1B))
#define FF ((bf16*)(ws + WS_FF))
#define GATES ((bf16*)out)

    for (int u = F.tid; u < (LDS_BYTES - LDSCTL_OFF) / 4; u += NWAVES * 64) ((LAS unsigned*)(F.lds + LDSCTL_OFF))[u] = 0u;
    __syncthreads();
    XcdBarrier bar; bar.bar = (unsigned*)(F.ctl + CW_BAR); bar.x = 0; bar.st = nullptr;
    if (N_LAUNCHES != PER_PHASE) bar = xcd_barrier_post((unsigned*)(F.ctl + CW_BAR), F.MISC + 8);
#define GRID_BAR() do { if (N_LAUNCHES != PER_PHASE) xcd_barrier(bar); } while (0)
    const int lo = args.ph_lo, hi = args.ph_hi;
#ifndef PH_MASK
#define PH_MASK 0xff
#endif
#define IN(k) (((PH_MASK >> (k)) & 1) && lo <= (k) && (k) < hi)
#define BOTH(k) (IN(k) && IN((k) + 1))
#ifdef PROBE_A
#define STAMP(k) do { if (F.tid == 0) F.MISC[12 + (k)] = (unsigned)rt(); } while (0)
#else
#define STAMP(k) do { } while (0)
#endif
    STAMP(0);

    if (IN(0)) {
        P0Args a{x_, g_mix, w_in, w_cpw, w_apw, w_out, g_ffn, w_fg, w_fu, w_fd, WIN, WCA, WO, WGU, WD, XB, RS1, ROPE};
        p0_prologue(F, a);
        if (BOTH(0)) GRID_BAR();
        STAMP(1);
    }
    if (IN(1)) {
        pg8::Gemm g{XB, WIN, M, INC, D}; pg8::StaticOrder S; S.init(M, INC, F.G, (int)blockIdx.x);
        pg8::EpiIn E{U, CA, KP, VP, GATES, RS1, b_gate, ROPE};
        pg8::gemm_phase<pg8::EpiIn, pg8::StaticOrder, true, true>(F.lds + RING_OFF, g, S, E);
        if (BOTH(1)) GRID_BAR();
        STAMP(2);
    }
    if (IN(2)) {
#ifndef NO_CONV
        { ConvArgs ca{U, CA, w_dw, b_dw, g_cln, b_cln};
          float w0[31], w1[31];
          { const float* wp = w_dw + 2 * F.tid;
            _Pragma("unroll") for (int j = 0; j < 31; ++j) { const f32x2 t = *(const f32x2*)wp; w0[j] = t.x; w1[j] = t.y; wp += D; asm volatile("" : "+v"(wp)); } }
          _Pragma("nounroll") for (int it = F.vcu * 4; it < M / 32; it += F.G * 4) { conv_dma(F, ca, it);
              _Pragma("nounroll") for (int k = 0; k < 4; ++k) conv_item(F, ca, it + k, k < 3 ? it + k + 1 : -1, w0, w1); }
          asm volatile("s_waitcnt vmcnt(0)" ::: "memory"); __syncthreads(); }
#endif
        STAMP(10);
#ifndef NO_ATTN
        const float d1 = wave_sum(lq1[F.lane] * lk1[F.lane]), d2 = wave_sum(lq2[F.lane] * lk2[F.lane]);
        const float lam = expf(d1) - expf(d2) + 0.2f;
#ifdef ATT_V1
        for (int v = F.vcu; v < 256; v += F.G) {
            const int bh = v >> 1, sub = v & 1;
            for (int i = 0; i < 8; ++i) { const int k = i >> 1; const int qb = (i & 1) ? (2 * k + sub) : (15 - 2 * k - sub);
                att::attn_unit(bh >> 3, bh & 7, qb, CA, KP, VP, g_sub, lam, F.lds + RING_OFF); }
        }
#else
        for (int v = F.vcu; v < 256; v += F.G) {
            const int bh = v >> 1, sub = v & 1; float* osc = (float*)(ws + WS_MERGED) + (size_t)v * (NWAVES * 4096);
#define ATT_UNIT(i) att2::UnitP{bh >> 3, bh & 7, (i) & 1, (((i) >> 1) & 1) ? (2 * ((i) >> 2) + sub) : (7 - 2 * ((i) >> 2) - sub)}
            att2::bf16x8 qr[4];
            att2::attn_issue(ATT_UNIT(0), KP, VP, (char*)lds + RING_OFF); att2::attn_loadq(ATT_UNIT(0), CA, qr);
            for (int i = 0; i < 8; ++i) att2::attn_unit<8>(ATT_UNIT(i), ATT_UNIT(i + 1), i < 7, qr, CA, KP, VP, osc, g_sub, lam, (char*)lds + RING_OFF);
#undef ATT_UNIT
        }
        asm volatile("s_waitcnt vmcnt(0)" ::: "memory"); __syncthreads();
#endif
#endif
        if (BOTH(2)) GRID_BAR();
        STAMP(3);
    }
    if (IN(3)) {
        pg8::Gemm g{CA, WCA, M, D, 2 * D}; pg8::StaticOrder S; S.init(M, D, F.G, (int)blockIdx.x);
        pg8::EpiMerge E{GATES, MERGED};
        pg8::gemm_phase<pg8::EpiMerge, pg8::StaticOrder, true, true>(F.lds + RING_OFF, g, S, E);
        if (BOTH(3)) GRID_BAR();
        STAMP(4);
    }
    if (IN(4)) {
        pg8::Gemm g{MERGED, WO, M, D, D}; pg8::StaticOrder S; S.init(M, D, F.G, (int)blockIdx.x);
        pg8::EpiResidB E{XB, X1B, PART1};
        pg8::gemm_phase<pg8::EpiResidB, pg8::StaticOrder, true, true>(F.lds + RING_OFF, g, S, E);
        if (BOTH(4)) GRID_BAR();
        STAMP(5);
    }
    if (IN(5)) {
        pg8::Gemm g{X1B, WGU, M, 2 * DFF, D}; pg8::StaticOrder S; S.init(M, 2 * DFF, F.G, (int)blockIdx.x);
        pg8::EpiUp E{PART1, FF, DFF};
        pg8::gemm_phase<pg8::EpiUp, pg8::StaticOrder, true, true>(F.lds + RING_OFF, g, S, E);
        if (BOTH(5)) GRID_BAR();
        STAMP(6);
    }
    if (IN(6)) {
        pg8::Gemm g{FF, WD, M, D, DFF}; pg8::StaticOrder S; S.init(M, D, F.G, (int)blockIdx.x);
        pg8::EpiResidF E{X1B, out, PART2};
        pg8::gemm_phase<pg8::EpiResidF, pg8::StaticOrder, true, true>(F.lds + RING_OFF, g, S, E);
        if (BOTH(6)) GRID_BAR();
        STAMP(7);
    }
    if (IN(7)) final_rows(F, out, PART2, g_fin);
#ifdef PROBE_A
    STAMP(8);
    if (blockIdx.x == 0 && F.tid == 0) { asm volatile("s_waitcnt vmcnt(0) lgkmcnt(0)" ::: "memory"); { const float t01 = (float)(F.MISC[12 + PROBE_B] - F.MISC[12 + PROBE_A]) * 0.1f; out[0] = floorf(t01 * (1.0f / PROBE_UNIT)) + 0.5f; } }
#endif
#undef IN
#undef BOTH
#undef GRID_BAR
#undef STAMP
#undef IN_
#undef x_
#undef g_mix
#undef w_in
#undef b_gate
#undef w_dw
#undef b_dw
#undef g_cln
#undef b_cln
#undef w_cpw
#undef lq1
#undef lk1
#undef lq2
#undef lk2
#undef g_sub
#undef w_apw
#undef w_out
#undef g_ffn
#undef w_fg
#undef w_fu
#undef w_fd
#undef g_fin
#undef out
#undef WIN
#undef WCA
#undef WO
#undef WGU
#undef WD
#undef ROPE
#undef RS1
#undef PART1
#undef PART2
#undef XB
#undef U
#undef CA
#undef VP
#undef KP
#undef MERGED
#undef X1B
#undef FF
#undef GATES
}

extern "C" void kernel_launch(void* const* d_in, const int* in_sizes, int n_in, void* d_out, int out_size, void* d_ws, size_t ws_size, hipStream_t stream) {
    static int grid = 0;
    if (grid == 0) {
        if (n_in != 21 || in_sizes[0] != M * D || out_size != M * D || ws_size < WS_END) { fprintf(stderr, "kernel_launch: unexpected problem: n_in %d in0 %d out %d ws %zu; nothing launched\n", n_in, n_in > 0 ? in_sizes[0] : -1, out_size, ws_size); grid = -1; return; }
        int dev = 0, cus = 0, per_cu = 0;
        if (hipGetDevice(&dev) != hipSuccess || hipDeviceGetAttribute(&cus, hipDeviceAttributeMultiprocessorCount, dev) != hipSuccess) { fprintf(stderr, "kernel_launch: device query failed\n"); grid = -1; return; }
        if (hipFuncSetAttribute((const void*)hyb_fwd, hipFuncAttributeMaxDynamicSharedMemorySize, LDS_BYTES) != hipSuccess) { fprintf(stderr, "kernel_launch: hipFuncSetAttribute failed\n"); grid = -1; return; }
        if (hipOccupancyMaxActiveBlocksPerMultiprocessor(&per_cu, (const void*)hyb_fwd, NWAVES * 64, LDS_BYTES) != hipSuccess || per_cu < 1)
            fprintf(stderr, "kernel_launch: note: occupancy query reports %d workgroups per CU\n", per_cu);
        (void)hipGetLastError();
        grid = cus;
        if (grid > 256) grid = 256;
    }
    if (grid < 0) return;
    if (hipMemsetAsync((char*)d_ws + WS_CTL, 0, CTL_ZERO_BYTES, stream) != hipSuccess) { fprintf(stderr, "kernel_launch: hipMemsetAsync failed\n"); return; }
    Args a{};
    for (int i = 0; i < 21; ++i) a.in[i] = (const float*)d_in[i];
    a.out = (float*)d_out; a.ws = (unsigned char*)d_ws;
    if (N_LAUNCHES == 1) { a.ph_lo = 0; a.ph_hi = PER_PHASE; a.li = 0; hipLaunchKernelGGL(hyb_fwd, dim3(grid), dim3(NWAVES * 64), LDS_BYTES, stream, a); }
    else for (int li = 0; li < PER_PHASE; ++li) { a.ph_lo = li; a.ph_hi = li + 1; a.li = li; hipLaunchKernelGGL(hyb_fwd, dim3(grid), dim3(NWAVES * 64), LDS_BYTES, stream, a); }
    const hipError_t le = hipPeekAtLastError();
    if (le != hipSuccess) fprintf(stderr, "kernel_launch: launch failed: %s\n", hipGetErrorName(le));
}
```
